# Optimizing an MI355X kernel written in HIP

```python
import jax, jax.numpy as jnp
from jax import lax
import numpy as np

D_MODEL = 1024
BATCH = 8
SEQ = 8192
DEPTH = 4

N_MIXERS = 3
GRID_W = 64
EPS = 1e-6
NEG_INF = -1e30
D_RNN = 1024
RG_BLOCKS = 8
RG_BLOCK_W = D_RNN // RG_BLOCKS
CONV_W = 4
CONV_LEFT = 2
RG_C = 8.0
HEAD_DIM = 128
GQA_HEADS = 8
GQA_KV_HEADS = 2
GQA_GROUP = GQA_HEADS // GQA_KV_HEADS
Q_BLOCK = 128
AXIAL_THETA = 10000.0
DIL_PATTERNS = ((128, 1), (512, 4), (2048, 16))
DIL_GROUPS = len(DIL_PATTERNS)
DIL_HEADS = 8
ROPE_THETA = 500000.0
ROT_DIMS = HEAD_DIM // 4
D_FF = 3584
N_EXPERTS = 8
TOP_K = 2
D_FF_EXPERT = 3584

kernel_name = 'hybrid_bidir_rglru_gqa_dilated_moe'


def rms_norm(x, g):
    xf = x.astype(jnp.float32)
    y = xf * lax.rsqrt(jnp.mean(xf * xf, axis=-1, keepdims=True) + EPS)
    return (y * g.astype(jnp.float32)).astype(x.dtype)


def inv_freq(dim, theta):
    return theta ** (-jnp.arange(0, dim, 2, dtype=jnp.float32) / dim)


def rope_half(x, ang):
    xf = x.astype(jnp.float32)
    n = ang.shape[-1]
    x1, x2 = xf[..., :n], xf[..., n:]
    c = jnp.cos(ang)[:, None, :]
    s = jnp.sin(ang)[:, None, :]
    return jnp.concatenate([x1 * c - x2 * s, x2 * c + x1 * s], axis=-1).astype(x.dtype)


def axial_rope(x, rows, cols):
    half = HEAD_DIM // 2
    xr = rope_half(x[..., :half], rows[:, None] * inv_freq(half, AXIAL_THETA)[None, :])
    xc = rope_half(x[..., half:], cols[:, None] * inv_freq(half, AXIAL_THETA)[None, :])
    return jnp.concatenate([xr, xc], axis=-1)


def partial_rope(x, pos):
    xr = rope_half(x[..., :ROT_DIMS], pos[:, None] * inv_freq(ROT_DIMS, ROPE_THETA)[None, :])
    return jnp.concatenate([xr, x[..., ROT_DIMS:]], axis=-1)


def swiglu(h, w_gate_up, w_down):
    g, u = jnp.split(h @ w_gate_up, 2, axis=-1)
    return (jax.nn.silu(g) * u) @ w_down


def dense_ffn(h, w_gate_up, w_down):
    return swiglu(h, w_gate_up, w_down)


def moe_ffn(h, router, router_b, w_gate_up, w_down):
    logits = (h @ router).astype(jnp.float32) + router_b.astype(jnp.float32)
    top_v, top_i = lax.top_k(logits, TOP_K)
    gates = jax.nn.softmax(top_v, axis=-1)
    combine = jnp.sum(jax.nn.one_hot(top_i, N_EXPERTS, dtype=jnp.float32) * gates[..., None], axis=-2)
    y = jnp.zeros(h.shape, jnp.float32)
    for e in range(N_EXPERTS):
        y = y + combine[..., e:e + 1] * swiglu(h, w_gate_up[e], w_down[e]).astype(jnp.float32)
    return y.astype(h.dtype)


def _linear_recurrence_combine(c1, c2):
    a1, b1 = c1
    a2, b2 = c2
    return (a1 * a2, a2 * b1 + b2)


def _rglru_scan(xs, w_a, b_a, w_x, b_x, lam):
    B, S, _ = xs.shape
    xb = xs.reshape(B, S, RG_BLOCKS, RG_BLOCK_W)

    def block_diag(w, b):
        return jnp.einsum('bsnc,ncd->bsnd', xb, w.astype(jnp.float32)).reshape(B, S, D_RNN) + b.astype(jnp.float32)

    r = jax.nn.sigmoid(block_diag(w_a, b_a))
    i = jax.nn.sigmoid(block_diag(w_x, b_x))
    log_a = -RG_C * r * jax.nn.softplus(-lam.astype(jnp.float32))
    a = jnp.exp(log_a)
    u = jnp.sqrt(-jnp.expm1(2.0 * log_a)) * (i * xs)
    _, hs = lax.associative_scan(_linear_recurrence_combine, (a, u), axis=1)
    return hs


def rglru_mixer(h, w_in, conv_w, conv_b, w_a, b_a, w_x, b_x, lam, w_out):
    S = h.shape[1]
    y_br, x_br = jnp.split(h @ w_in, 2, axis=-1)
    xp = jnp.pad(x_br, ((0, 0), (CONV_LEFT, CONV_W - 1 - CONV_LEFT), (0, 0)))
    xc = conv_b + xp[:, 0:S] * conv_w[0]
    for j in range(1, CONV_W):
        xc = xc + xp[:, j:j + S] * conv_w[j]
    xf = xc.astype(jnp.float32)
    h_fwd = _rglru_scan(xf, w_a[0], b_a[0], w_x[0], b_x[0], lam[0])
    h_bwd = jnp.flip(_rglru_scan(jnp.flip(xf, 1), w_a[1], b_a[1], w_x[1], b_x[1], lam[1]), 1)
    out = jax.nn.gelu(y_br.astype(jnp.float32)) * (h_fwd + h_bwd)
    return out.astype(h.dtype) @ w_out


def gqa_axial_mixer(h, w_qkv, q_gain, k_gain, w_out):
    B, S, _ = h.shape
    rows_n = S // GRID_W
    qkv = h @ w_qkv
    nq = GQA_HEADS * HEAD_DIM
    nkv = GQA_KV_HEADS * HEAD_DIM
    q = qkv[..., :nq].reshape(B, S, GQA_HEADS, HEAD_DIM)
    k = qkv[..., nq:nq + nkv].reshape(B, S, GQA_KV_HEADS, HEAD_DIM)
    v = qkv[..., nq + nkv:].reshape(B, S, GQA_KV_HEADS, HEAD_DIM)
    rows = jnp.repeat(jnp.arange(rows_n), GRID_W).astype(jnp.float32)
    cols = jnp.tile(jnp.arange(GRID_W), rows_n).astype(jnp.float32)
    q = axial_rope(rms_norm(q, q_gain), rows, cols)
    k = axial_rope(rms_norm(k, k_gain), rows, cols)
    scale = HEAD_DIM ** -0.5
    qb = q.reshape(B, S // Q_BLOCK, Q_BLOCK, GQA_KV_HEADS, GQA_GROUP, HEAD_DIM).transpose(1, 0, 2, 3, 4, 5)

    def attend_block(qi):
        s = jnp.einsum('bqngd,bsnd->bngqs', qi, k).astype(jnp.float32) * scale
        p = jax.nn.softmax(s, axis=-1).astype(v.dtype)
        return jnp.einsum('bngqs,bsnd->bqngd', p, v)

    o = lax.map(attend_block, qb)
    o = o.transpose(1, 0, 2, 3, 4, 5).reshape(B, S, GQA_HEADS * HEAD_DIM)
    return o @ w_out


def dilated_band_attention(q, k, v, dil, span):
    B, S, H, Dh = q.shape
    unit = dil * span
    Sp = -(-S // unit) * unit
    M = Sp // dil
    nb = M // span
    pad = ((0, 0), (0, Sp - S), (0, 0), (0, 0))

    def to_res(t):
        return jnp.pad(t, pad).reshape(B, M, dil, H, Dh).transpose(0, 2, 1, 3, 4).reshape(B, dil, nb, span, H, Dh)

    def band(t):
        tp = jnp.pad(t, [(0, 0), (0, 0), (1, 1)] + [(0, 0)] * (t.ndim - 3))
        return jnp.concatenate([tp[:, :, :-2], tp[:, :, 1:-1], tp[:, :, 2:]], axis=3)

    def from_res(t):
        rest = t.shape[4:]
        return t.reshape((B, dil, M) + rest).swapaxes(1, 2).reshape((B, Sp) + rest)[:, :S]

    qr = to_res(q)
    kr = band(to_res(k))
    vr = band(to_res(v)).astype(jnp.float32)
    key_ok = (jnp.arange(Sp) < S).reshape(M, dil).T.reshape(1, dil, nb, span)
    key_ok = band(key_ok)[0]
    rel = jnp.arange(3 * span)[None, :] - span - jnp.arange(span)[:, None]
    rel_ok = jnp.abs(rel) <= span
    mask = rel_ok[None, None, None] & key_ok[:, :, None, None, :]
    s = jnp.einsum('brnqhd,brnkhd->brnhqk', qr, kr).astype(jnp.float32) * (Dh ** -0.5)
    s = jnp.where(mask, s, NEG_INF)
    m = jnp.max(s, axis=-1, keepdims=True)
    p = jnp.exp(s - m)
    l = jnp.sum(p, axis=-1, keepdims=True)
    o = jnp.einsum('brnhqk,brnkhd->brnqhd', p / l, vr)
    lse = (m + jnp.log(l))[..., 0].transpose(0, 1, 2, 4, 3)
    return from_res(o), from_res(lse)


def dilated_mixer(h, w_qkv, q_gain, k_gain, w_out):
    B, S, _ = h.shape
    qkv = (h @ w_qkv).reshape(B, S, DIL_GROUPS, 3, DIL_HEADS, HEAD_DIM)
    pos = jnp.arange(S, dtype=jnp.float32)
    outs = []
    lses = []
    for g, (window, dil) in enumerate(DIL_PATTERNS):
        span = window // (2 * dil)
        q = partial_rope(rms_norm(qkv[:, :, g, 0], q_gain), pos)
        k = partial_rope(rms_norm(qkv[:, :, g, 1], k_gain), pos)
        o, lse = dilated_band_attention(q, k, qkv[:, :, g, 2], dil, span)
        outs.append(o)
        lses.append(lse)
    w = jax.nn.softmax(jnp.stack(lses, axis=0), axis=0)[..., None]
    o = jnp.sum(jnp.stack(outs, axis=0) * w, axis=0)
    return o.reshape(B, S, DIL_HEADS * HEAD_DIM).astype(h.dtype) @ w_out


def setup_inputs(seed: int = 0) -> dict:
    key = jax.random.key(seed)
    ks = iter(jax.random.split(key, 64))

    def w(shape, fan_in):
        return jax.random.normal(next(ks), shape, jnp.float32) * fan_in ** -0.5

    def gain(n):
        return 1.0 + 0.05 * jax.random.normal(next(ks), (n,), jnp.float32)

    def bias(shape, scale=0.02):
        return scale * jax.random.normal(next(ks), shape, jnp.float32)

    p = {'x': jax.random.normal(next(ks), (BATCH, SEQ, D_MODEL), jnp.float32)}

    def add_rglru(pre):
        p[pre + 'attn_norm'] = gain(D_MODEL)
        p[pre + 'rg_w_in'] = w((D_MODEL, 2 * D_RNN), D_MODEL)
        p[pre + 'rg_conv_w'] = w((CONV_W, D_RNN), CONV_W)
        p[pre + 'rg_conv_b'] = bias((D_RNN,))
        p[pre + 'rg_w_a'] = w((2, RG_BLOCKS, RG_BLOCK_W, RG_BLOCK_W), RG_BLOCK_W)
        p[pre + 'rg_b_a'] = bias((2, D_RNN))
        p[pre + 'rg_w_x'] = w((2, RG_BLOCKS, RG_BLOCK_W, RG_BLOCK_W), RG_BLOCK_W)
        p[pre + 'rg_b_x'] = bias((2, D_RNN))
        a0 = jax.random.uniform(next(ks), (2, D_RNN), jnp.float32, 0.9, 0.999)
        sa = a0 ** (1.0 / RG_C)
        p[pre + 'rg_lambda'] = jnp.log(sa) - jnp.log1p(-sa)
        p[pre + 'rg_w_out'] = w((D_RNN, D_MODEL), D_RNN)

    def add_gqa(pre):
        p[pre + 'attn_norm'] = gain(D_MODEL)
        p[pre + 'gqa_w_qkv'] = w((D_MODEL, (GQA_HEADS + 2 * GQA_KV_HEADS) * HEAD_DIM), D_MODEL)
        p[pre + 'gqa_q_norm'] = gain(HEAD_DIM)
        p[pre + 'gqa_k_norm'] = gain(HEAD_DIM)
        p[pre + 'gqa_w_out'] = w((GQA_HEADS * HEAD_DIM, D_MODEL), GQA_HEADS * HEAD_DIM)

    def add_dil(pre):
        p[pre + 'attn_norm'] = gain(D_MODEL)
        p[pre + 'dil_w_qkv'] = w((D_MODEL, DIL_GROUPS * 3 * DIL_HEADS * HEAD_DIM), D_MODEL)
        p[pre + 'dil_q_norm'] = gain(HEAD_DIM)
        p[pre + 'dil_k_norm'] = gain(HEAD_DIM)
        p[pre + 'dil_w_out'] = w((DIL_HEADS * HEAD_DIM, D_MODEL), DIL_HEADS * HEAD_DIM)

    def add_dense(pre):
        p[pre + 'ffn_norm'] = gain(D_MODEL)
        p[pre + 'ffn_w_gate_up'] = w((D_MODEL, 2 * D_FF), D_MODEL)
        p[pre + 'ffn_w_down'] = w((D_FF, D_MODEL), D_FF)

    def add_moe(pre):
        p[pre + 'ffn_norm'] = gain(D_MODEL)
        p[pre + 'moe_router'] = w((D_MODEL, N_EXPERTS), D_MODEL)
        p[pre + 'moe_router_b'] = bias((N_EXPERTS,), 0.01)
        p[pre + 'moe_w_gate_up'] = w((N_EXPERTS, D_MODEL, 2 * D_FF_EXPERT), D_MODEL)
        p[pre + 'moe_w_down'] = w((N_EXPERTS, D_FF_EXPERT, D_MODEL), D_FF_EXPERT)

    add_rglru('l0_')
    add_dense('l0_')
    add_gqa('l1_')
    add_moe('l1_')
    add_dil('l2_')
    add_dense('l2_')
    add_rglru('l3_')
    add_moe('l3_')
    return p


def reference(x, l0_attn_norm, l0_rg_w_in, l0_rg_conv_w, l0_rg_conv_b, l0_rg_w_a, l0_rg_b_a, l0_rg_w_x, l0_rg_b_x, l0_rg_lambda, l0_rg_w_out, l0_ffn_norm, l0_ffn_w_gate_up, l0_ffn_w_down, l1_attn_norm, l1_gqa_w_qkv, l1_gqa_q_norm, l1_gqa_k_norm, l1_gqa_w_out, l1_ffn_norm, l1_moe_router, l1_moe_router_b, l1_moe_w_gate_up, l1_moe_w_down, l2_attn_norm, l2_dil_w_qkv, l2_dil_q_norm, l2_dil_k_norm, l2_dil_w_out, l2_ffn_norm, l2_ffn_w_gate_up, l2_ffn_w_down, l3_attn_norm, l3_rg_w_in, l3_rg_conv_w, l3_rg_conv_b, l3_rg_w_a, l3_rg_b_a, l3_rg_w_x, l3_rg_b_x, l3_rg_lambda, l3_rg_w_out, l3_ffn_norm, l3_moe_router, l3_moe_router_b, l3_moe_w_gate_up, l3_moe_w_down):
    mixers = (rglru_mixer, gqa_axial_mixer, dilated_mixer)
    attn_norms = [l0_attn_norm, l1_attn_norm, l2_attn_norm, l3_attn_norm]
    ffn_norms = [l0_ffn_norm, l1_ffn_norm, l2_ffn_norm, l3_ffn_norm]
    mixer_params = [
        (l0_rg_w_in, l0_rg_conv_w, l0_rg_conv_b, l0_rg_w_a, l0_rg_b_a, l0_rg_w_x, l0_rg_b_x, l0_rg_lambda, l0_rg_w_out),
        (l1_gqa_w_qkv, l1_gqa_q_norm, l1_gqa_k_norm, l1_gqa_w_out),
        (l2_dil_w_qkv, l2_dil_q_norm, l2_dil_k_norm, l2_dil_w_out),
        (l3_rg_w_in, l3_rg_conv_w, l3_rg_conv_b, l3_rg_w_a, l3_rg_b_a, l3_rg_w_x, l3_rg_b_x, l3_rg_lambda, l3_rg_w_out),
    ]
    ffn_params = [
        (l0_ffn_w_gate_up, l0_ffn_w_down),
        (l1_moe_router, l1_moe_router_b, l1_moe_w_gate_up, l1_moe_w_down),
        (l2_ffn_w_gate_up, l2_ffn_w_down),
        (l3_moe_router, l3_moe_router_b, l3_moe_w_gate_up, l3_moe_w_down),
    ]
    for i in range(DEPTH):
        x = x + mixers[i % N_MIXERS](rms_norm(x, attn_norms[i]), *mixer_params[i])
        ffn = dense_ffn if i % 2 == 0 else moe_ffn
        x = x + ffn(rms_norm(x, ffn_norms[i]), *ffn_params[i])
    return x
```

```cpp
#include <hip/hip_runtime.h>
#include <cstdio>
#include <cstdint>

#ifndef SPLIT_LAUNCHES
#define SPLIT_LAUNCHES 0
#endif
#ifndef K_ROT
#define K_ROT 1
#endif
#ifndef FP8_RES
#define FP8_RES 0xC
#endif
#ifndef LATE_CVT
#define LATE_CVT 1
#endif
#ifndef PROBE_EPI
#define PROBE_EPI 0
#endif
#ifndef DUP_MASK
#define DUP_MASK 0u
#endif
#ifndef FP8_GU
#define FP8_GU 0xE
#endif
#ifndef FP8_DN
#define FP8_DN 0xE
#endif
#ifndef FP8_QKV2
#define FP8_QKV2 1
#endif
#ifndef FP8_QKV1
#define FP8_QKV1 1
#endif
#ifndef FP8_WIN
#define FP8_WIN 0x0
#endif
#define F8GU(L) ((((FP8_GU) >> (L)) & 1) != 0)
#define F8DN(L) ((((FP8_DN) >> (L)) & 1) != 0)
#ifndef FP8_QKVD
#define FP8_QKVD 1
#endif
#ifndef FP8_ATTN
#define FP8_ATTN 1
#endif
#ifndef GEMM_STAGGER
#define GEMM_STAGGER 0
#endif
#ifndef PHASE_LIMIT
#define PHASE_LIMIT 1000
#endif

#define LAS __attribute__((address_space(3)))
typedef unsigned short bf16_t;
typedef short bf16x8 __attribute__((ext_vector_type(8)));
typedef short s16x4 __attribute__((ext_vector_type(4)));
typedef float f32x4 __attribute__((ext_vector_type(4)));
typedef float f32x2 __attribute__((ext_vector_type(2)));
typedef float f32x16 __attribute__((ext_vector_type(16)));
typedef unsigned u32x4 __attribute__((ext_vector_type(4)));
typedef unsigned u32x2 __attribute__((ext_vector_type(2)));

constexpr int DM = 1024, NBATCH = 8, SEQ = 8192, MT = NBATCH * SEQ;
constexpr int DFF = 3584, NEXP = 8;
constexpr int RG_L = 64, RG_NCH = SEQ / RG_L;
constexpr int DIL_CB = 2, DIL_ROWS = DIL_CB * SEQ, DIL_N = 9216;
constexpr float EPS = 1e-6f;
constexpr int NWG = 256;

constexpr size_t MiB = 1024 * 1024;
constexpr size_t WS_CTL   = 0;
constexpr size_t WS_TCNT  = 65536;
constexpr size_t WS_META  = WS_TCNT + 16384;
constexpr size_t WS_TOPE  = WS_META + 8192;
constexpr size_t WS_TOPG  = WS_TOPE + (size_t)MT * 8;
constexpr size_t WS_LRANK = WS_TOPG + (size_t)MT * 8;
constexpr int    SROWS    = 2 * MT + 16 * 256;
constexpr size_t WS_SIDX  = WS_LRANK + (size_t)MT * 8;
constexpr size_t WS_SGATE = WS_SIDX + (size_t)SROWS * 4;
constexpr size_t WS_SRS   = WS_SGATE + (size_t)SROWS * 4;
constexpr size_t WS_SUMP  = WS_SRS + (size_t)SROWS * 4;
constexpr size_t RG_SUMB  = (size_t)NBATCH * RG_NCH * 2 * 1024 * 4;
constexpr size_t WS_SUMH  = WS_SUMP + RG_SUMB;
constexpr size_t WS_CARRY = WS_SUMH + RG_SUMB;
constexpr size_t WS_LSE   = WS_CARRY + RG_SUMB;
constexpr size_t WS_T1    = WS_LSE + (size_t)3 * DIL_ROWS * 8 * 4;
constexpr size_t WS_T2    = WS_T1 + (size_t)128 * 32 * 8;
constexpr size_t WS_SS    = WS_T2 + (size_t)SEQ * 16 * 8;
constexpr size_t WS_WB    = (WS_SS + (size_t)2 * MT * 64 + 4095) & ~(size_t)4095;
constexpr size_t E_WIN = (size_t)2048 * 1024, E_GATE = (size_t)2 * 2 * 8 * 128 * 128, E_WOUT = (size_t)1024 * 1024, E_WGU = (size_t)7168 * 1024, E_WD = (size_t)1024 * 3584;
constexpr size_t E_QKV1 = (size_t)1536 * 1024, E_QKV2 = (size_t)9216 * 1024;
constexpr size_t O_L0_WIN = 0, O_L0_GATE = O_L0_WIN + E_WIN, O_L0_WOUT = O_L0_GATE + E_GATE, O_L0_WGU = O_L0_WOUT + E_WOUT, O_L0_WD = O_L0_WGU + E_WGU;
constexpr size_t O_L1_QKV = O_L0_WD + E_WD, O_L1_WOUT = O_L1_QKV + E_QKV1, O_L1_WGU = O_L1_WOUT + E_WOUT, O_L1_WD = O_L1_WGU + 8 * E_WGU;
constexpr size_t O_L2_QKV = O_L1_WD + 8 * E_WD, O_L2_WOUT = O_L2_QKV + E_QKV2, O_L2_WGU = O_L2_WOUT + E_WOUT, O_L2_WD = O_L2_WGU + E_WGU;
constexpr size_t O_L3_WIN = O_L2_WD + E_WD, O_L3_GATE = O_L3_WIN + E_WIN, O_L3_WOUT = O_L3_GATE + E_GATE, O_L3_WGU = O_L3_WOUT + E_WOUT, O_L3_WD = O_L3_WGU + 8 * E_WGU;
constexpr size_t E_WTOT = O_L3_WD + 8 * E_WD;
constexpr size_t WS_XB  = (WS_WB + E_WTOT * 2 + 4095) & ~(size_t)4095;
constexpr size_t WS_BIG = WS_XB + (size_t)MT * DM * 2;
constexpr size_t OUT_AO8 = (size_t)MT * DM * 3;
constexpr size_t OUT_X8 = (size_t)MT * DM * 2;
constexpr size_t BIG_BYTES = 496 * MiB;
constexpr size_t WS_END = WS_BIG + BIG_BYTES;
constexpr size_t BIG_OG = (size_t)DIL_ROWS * DIL_N * 2;
constexpr size_t BIG_HIDR = 224 * MiB;
constexpr size_t BIG_Y = 240 * MiB;
static_assert(BIG_HIDR + (size_t)8 * 256 * DFF * 2 <= BIG_Y && BIG_Y + (size_t)2 * MT * DM * 2 <= BIG_BYTES, "BIG map");
constexpr int LDS_GIX = 131072 + 256 + 16384;
constexpr int LDS_RSL = 131072 + 256;
constexpr int LDS_BYTES = 151552;
constexpr int LDS_BAR = 151552 - 256;

#define XB_TMO      128
#define XB_XCNT(j)  (256  + 64 * (j))
#define XB_XSUB(j)  (1280 + 64 * (j))
#define XB_XGEN(j)  (2304 + 64 * (j))
#define XB_TOP      3328
#define XB_TOPGEN   3392
#define XCD_BAR_WORDS 3456
#define XB_SPIN_CAP (1u << 18)
__device__ __forceinline__ unsigned xb_ld(unsigned* p)              { return __hip_atomic_load(p, __ATOMIC_RELAXED, __HIP_MEMORY_SCOPE_AGENT); }
__device__ __forceinline__ unsigned xb_add(unsigned* p, unsigned v) { return __hip_atomic_fetch_add(p, v, __ATOMIC_RELAXED, __HIP_MEMORY_SCOPE_AGENT); }
__device__ __forceinline__ unsigned xb_xcc_id() { return (unsigned)__builtin_amdgcn_s_getreg((3 << 11) | 20) & 0xFu; }
#define XB_SPIN(cond, bar) do { unsigned _sp = 0; while (cond) { __builtin_amdgcn_s_sleep(1); \
    if ((++_sp & 255u) == 0u) { if (xb_ld(&(bar)[XB_TMO])) break; if (_sp > XB_SPIN_CAP) { atomicAdd(&(bar)[XB_TMO], 1u); break; } } } } while (0)
struct XcdBarrier { unsigned* bar; unsigned x; volatile LAS unsigned* st; };
__device__ __forceinline__ int lane_id();
__device__ __forceinline__ XcdBarrier xcd_barrier_post(unsigned* bar, volatile LAS unsigned* st, bool t0) {
    XcdBarrier b; b.bar = bar; b.x = xb_xcc_id(); b.st = st;
    if (t0) (void)xb_add(&bar[XB_XCNT(b.x)], 1u);
    return b;
}
__device__ __forceinline__ void xcd_barrier_complete(unsigned* bar, unsigned x, unsigned& nloc, unsigned& nx) {
    const unsigned G = gridDim.x * gridDim.y * gridDim.z;
    unsigned sum, cnt, mine, sp = 0u;
    for (;;) {
        sum = 0u; cnt = 0u; mine = 0u;
#pragma unroll
        for (unsigned j = 0; j < 16; ++j) { const unsigned c = xb_ld(&bar[XB_XCNT(j)]); sum += c; cnt += (c > 0u) ? 1u : 0u; mine = (j == x) ? c : mine; }
        if (sum == G) break;
        __builtin_amdgcn_s_sleep(1);
        if ((++sp & 255u) == 0u) { if (xb_ld(&bar[XB_TMO])) break; if (sp > XB_SPIN_CAP) { atomicAdd(&bar[XB_TMO], 1u); break; } }
    }
    nloc = mine > 0u ? mine : 1u; nx = cnt > 0u ? cnt : 1u;
}
__device__ __forceinline__ void xcd_barrier(const XcdBarrier& b, bool t0) {
    asm volatile("s_waitcnt vmcnt(0)" ::: "memory");
    __syncthreads();
    if (t0) {
        unsigned* bar = b.bar;
        __builtin_amdgcn_s_waitcnt(0);
        unsigned nloc = b.st[0], nx = b.st[1];
        if (nloc == 0u) { xcd_barrier_complete(bar, b.x, nloc, nx); b.st[0] = nloc; b.st[1] = nx; }
        const unsigned old = xb_add(&bar[XB_XSUB(b.x)], 1u);
        const unsigned gen = old / nloc;
        if (old + 1u == (gen + 1u) * nloc) {
            __builtin_amdgcn_fence(__ATOMIC_RELEASE, "agent");
            asm volatile("s_waitcnt vmcnt(0)" ::: "memory");
            const unsigned og = xb_add(&bar[XB_TOP], 1u);
            const unsigned tg = og / nx;
            if (og + 1u == (tg + 1u) * nx) xb_add(&bar[XB_TOPGEN], 1u);
            else XB_SPIN(xb_ld(&bar[XB_TOPGEN]) == tg, bar);
            __builtin_amdgcn_fence(__ATOMIC_ACQUIRE, "agent");
            xb_add(&bar[XB_XGEN(b.x)], 1u);
            asm volatile("s_waitcnt vmcnt(0)" ::: "memory");
        } else {
            XB_SPIN(xb_ld(&bar[XB_XGEN(b.x)]) == gen, bar);
            __builtin_amdgcn_fence(__ATOMIC_ACQUIRE, "agent");
            asm volatile("s_waitcnt vmcnt(0)" ::: "memory");
        }
    }
    __syncthreads();
}

__device__ __forceinline__ int lane_id() { int l; asm volatile("v_mbcnt_lo_u32_b32 %0, -1, 0\n\tv_mbcnt_hi_u32_b32 %0, -1, %0" : "=v"(l)); return l; }
__device__ __forceinline__ int fresh_tid(int wv) { int w = wv; asm volatile("" : "+s"(w)); return (w << 6) | lane_id(); }
#define GAS __attribute__((address_space(1)))
template <class T> __device__ __forceinline__ T* fresh_ptr(T* p) { GAS T* q = (GAS T*)p; asm volatile("" : "+s"(q)); return (T*)q; }
__device__ __forceinline__ unsigned cvt_pk_bf16(float lo, float hi) { unsigned r; asm volatile("v_cvt_pk_bf16_f32 %0, %1, %2" : "=v"(r) : "v"(lo), "v"(hi)); return r; }
typedef int v8i __attribute__((ext_vector_type(8)));
typedef int i32x4 __attribute__((ext_vector_type(4)));
constexpr int F8S_HN = 1, F8S_WGU = 5, F8S_HID = 2, F8S_WD = 6, F8S_AO = 0;
constexpr int e8m0x4(int s) { return (127 - s) * 0x01010101; }
__device__ __forceinline__ unsigned cvt_pk4_fp8(float a, float b, float c, float d) {
    a = __builtin_amdgcn_fmed3f(a, -448.f, 448.f); b = __builtin_amdgcn_fmed3f(b, -448.f, 448.f); c = __builtin_amdgcn_fmed3f(c, -448.f, 448.f); d = __builtin_amdgcn_fmed3f(d, -448.f, 448.f);
    int w = 0; w = __builtin_amdgcn_cvt_pk_fp8_f32(a, b, w, false); w = __builtin_amdgcn_cvt_pk_fp8_f32(c, d, w, true); return (unsigned)w;
}
__device__ __forceinline__ float bf2f(short s) { return __uint_as_float(((unsigned)(unsigned short)s) << 16); }
__device__ __forceinline__ float shfl_xor_l(float v, int m, int lane) { return __int_as_float(__builtin_amdgcn_ds_bpermute((lane ^ m) << 2, __float_as_int(v))); }
template <int CTRL> __device__ __forceinline__ float dpp_mov(float v) { return __int_as_float(__builtin_amdgcn_update_dpp(0, __float_as_int(v), CTRL, 0xf, 0xf, true)); }
__device__ __forceinline__ float row16_sum(float v) { v += dpp_mov<0xB1>(v); v += dpp_mov<0x4E>(v); v += dpp_mov<0x141>(v); v += dpp_mov<0x140>(v); return v; }
__device__ __forceinline__ float wave_sum(float v, int lane) {
#pragma unroll
    for (int o = 1; o < 64; o <<= 1) v += shfl_xor_l(v, o, lane);
    return v;
}
__device__ __forceinline__ float silu_f(float g) { return g * __builtin_amdgcn_rcpf(1.0f + __builtin_amdgcn_exp2f(-1.4426950408889634f * g)); }
__device__ __forceinline__ float sigmoid_f(float g) { return __builtin_amdgcn_rcpf(1.0f + __builtin_amdgcn_exp2f(-1.4426950408889634f * g)); }
__device__ __forceinline__ float gelu_tanh_f(float x) {
    const float z = x * (1.0f + 0.044715f * x * x);
    return x * __builtin_amdgcn_rcpf(1.0f + __builtin_amdgcn_exp2f(-2.0f * 0.7978845608028654f * 1.4426950408889634f * z));
}

namespace pg8 {
constexpr int BM = 256, BK = 64, HALF = 128, HTB = HALF * BK * 2, STAGE_BYTES = 8 * HTB, NXCD = 8, WGM = 8;
__host__ __device__ __forceinline__ int lds_byte(int r, int c) { const int st = (r >> 4) * 2 + (c >> 5), rr = r & 15, cc = c & 31, ob = rr * 64 + cc * 2; return st * 1024 + (ob ^ (((ob >> 9) & 1) << 5)); }
__host__ __device__ __forceinline__ void stage_rc(int b, int& R, int& C) { const int st = b / 1024, sb = b % 1024, swz = sb ^ (((sb >> 9) & 1) << 5); R = (st >> 1) * 16 + swz / 64; C = (st & 1) * 32 + (swz % 64) / 2; }
__host__ __device__ __forceinline__ int perm32(int rho) { const int n = rho >> 4, i = rho & 15; return 8 * (i >> 2) + 4 * n + (i & 3); }

struct Unit { int pm, pn, e; };
struct Sched {
    const char* A; const char* B; size_t b_estride; const int* tile_e; const int* gidx;
    int nM, nN, G, c, t0;
    int a_tm;
    const char* rs;
    const char* rs2;
    int hot;
    __device__ __forceinline__ bool next(int i, Unit& u) const {
        const int nwg = nM * nN; const long L = (long)i * G + c; if (L >= nwg) return false;
        int wgid = (int)L; { const int q = nwg / NXCD, r = nwg % NXCD, xcd = wgid % NXCD, off = wgid / NXCD; wgid = (xcd < r ? xcd * (q + 1) : r * (q + 1) + (xcd - r) * q) + off; }
        const int nig = WGM * nN, gid = wgid / nig, fm = gid * WGM, gsz = (nM - fm) < WGM ? (nM - fm) : WGM;
        u.pm = fm + ((wgid % nig) % gsz); u.pn = (wgid % nig) / gsz;
        u.e = 0;
        return true;
    }
};

typedef float ss_t;
__device__ __forceinline__ float ss_row(const ss_t* ss, int row) { const f32x4* p = (const f32x4*)(ss + (size_t)row * 16); const f32x4 a = p[0], b = p[1], c = p[2], d = p[3];
    return (((a[0] + a[1]) + (a[2] + a[3])) + ((b[0] + b[1]) + (b[2] + b[3]))) + (((c[0] + c[1]) + (c[2] + c[3])) + ((d[0] + d[1]) + (d[2] + d[3]))); }
__device__ __forceinline__ float rstd_of(const ss_t* ss, int row) { return 1.0f / sqrtf(ss_row(ss, row) * (1.0f / DM) + EPS); }
__device__ __forceinline__ float rs_lds(const LAS unsigned char* rsl, int mode, int lr) {
    if (mode == 1) return *(const LAS float*)(rsl + lr * 64);
    return *(const LAS float*)(rsl + lr * 4); }
__device__ __forceinline__ void rs_reduce_lds(LAS unsigned char* rsl, int row) {
    const LAS f32x4* p = (const LAS f32x4*)(rsl + row * 64); const f32x4 a = p[0], b = p[1], c = p[2], d = p[3];
    const float t = (((a[0] + a[1]) + (a[2] + a[3])) + ((b[0] + b[1]) + (b[2] + b[3]))) + (((c[0] + c[1]) + (c[2] + c[3])) + ((d[0] + d[1]) + (d[2] + d[3])));
    *(LAS float*)(rsl + row * 64) = __builtin_amdgcn_rsqf(t * (1.0f / DM) + EPS);
}
struct EpiResid {
    static constexpr bool PERM = true; static constexpr int RSMODE = 0;
    bf16_t* X; ss_t* ss_out; int row0; unsigned char* x8;
    __device__ __forceinline__ void operator()(const f32x4 (&acc)[2][2][4][2], const Unit& u, int wr, int wc, int fr, int fq, const LAS unsigned char*) const {
        const int r0 = row0 + u.pm * BM + wr * 64 + fr, c0 = u.pn * BM + wc * 32 + 8 * fq; const int lane = fr + 16 * fq;
#pragma unroll
        for (int ai = 0; ai < 2; ++ai) {
            u32x4 xb[4][2];
#pragma unroll
            for (int m = 0; m < 4; ++m)
#pragma unroll
                for (int bj = 0; bj < 2; ++bj) xb[m][bj] = *(const u32x4*)(X + (size_t)(r0 + ai * HALF + m * 16) * DM + c0 + bj * HALF);
            asm volatile("" ::: "memory");
#pragma unroll
            for (int m = 0; m < 4; ++m) { const int row = r0 + ai * HALF + m * 16; bf16_t* xp = X + (size_t)row * DM + c0; float sq = 0.f;
#pragma unroll
                for (int bj = 0; bj < 2; ++bj) { const u32x4 b = xb[m][bj]; const f32x4 a0 = acc[ai][bj][m][0], a1 = acc[ai][bj][m][1];
                    float v[8];
                    v[0] = __uint_as_float(b.x << 16) + a0[0]; v[1] = __uint_as_float(b.x & 0xffff0000u) + a0[1]; v[2] = __uint_as_float(b.y << 16) + a0[2]; v[3] = __uint_as_float(b.y & 0xffff0000u) + a0[3];
                    v[4] = __uint_as_float(b.z << 16) + a1[0]; v[5] = __uint_as_float(b.z & 0xffff0000u) + a1[1]; v[6] = __uint_as_float(b.w << 16) + a1[2]; v[7] = __uint_as_float(b.w & 0xffff0000u) + a1[3];
#pragma unroll
                    for (int j = 0; j < 8; ++j) sq += v[j] * v[j];
                    u32x4 w; w.x = cvt_pk_bf16(v[0], v[1]); w.y = cvt_pk_bf16(v[2], v[3]); w.z = cvt_pk_bf16(v[4], v[5]); w.w = cvt_pk_bf16(v[6], v[7]);
                    *(u32x4*)(xp + bj * HALF) = w;
                    if (x8) { constexpr float sc = (float)(1 << F8S_HN); u32x2 q; q.x = cvt_pk4_fp8(v[0] * sc, v[1] * sc, v[2] * sc, v[3] * sc); q.y = cvt_pk4_fp8(v[4] * sc, v[5] * sc, v[6] * sc, v[7] * sc);
                        *(u32x2*)(x8 + (size_t)row * DM + c0 + bj * HALF) = q; } }
                sq += shfl_xor_l(sq, 16, lane); sq += shfl_xor_l(sq, 32, lane);
                if (fq == 0) ss_out[(size_t)row * 16 + u.pn * 4 + wc] = sq; }
        }
    }
};
struct EpiMoeY {
    static constexpr bool PERM = true; static constexpr int RSMODE = 3;
    bf16_t* Y;
    __device__ __forceinline__ void operator()(const f32x4 (&acc)[2][2][4][2], const Unit& u, int wr, int wc, int fr, int fq, const LAS unsigned char* rsl) const {
        const int c0 = u.pn * BM + wc * 32 + 8 * fq;
#pragma unroll
        for (int ai = 0; ai < 2; ++ai)
#pragma unroll
            for (int m = 0; m < 4; ++m) { const int lr = wr * 64 + fr + ai * HALF + m * 16; const int v = *(const LAS int*)(rsl + lr * 4);
                if (v >= 0) { const float g = *(const LAS float*)(rsl + 1024 + lr * 4); bf16_t* yp = Y + ((size_t)(v >> 20) * MT + (size_t)(v & 0xFFFFF)) * DM + c0;
#pragma unroll
                    for (int bj = 0; bj < 2; ++bj) { const f32x4 v0 = g * acc[ai][bj][m][0], v1 = g * acc[ai][bj][m][1];
                        u32x4 w; w.x = cvt_pk_bf16(v0[0], v0[1]); w.y = cvt_pk_bf16(v0[2], v0[3]); w.z = cvt_pk_bf16(v1[0], v1[1]); w.w = cvt_pk_bf16(v1[2], v1[3]);
                        *(u32x4*)(yp + bj * HALF) = w; } } }
    }
};
template <bool F8OUT, int RSM>
struct EpiSwiglu {
    static constexpr bool PERM = true; static constexpr int RSMODE = RSM;
    void* H;
    __device__ __forceinline__ void operator()(const f32x4 (&acc)[2][2][4][2], const Unit& u, int wr, int wc, int fr, int fq, const LAS unsigned char* rsl) const {
#pragma unroll
        for (int ai = 0; ai < 2; ++ai)
#pragma unroll
            for (int m = 0; m < 4; ++m) { const float rs = rs_lds(rsl, RSM, wr * 64 + fr + ai * HALF + m * 16);
                const f32x4 g0 = acc[ai][0][m][0], g1 = acc[ai][0][m][1], u0 = acc[ai][1][m][0], u1 = acc[ai][1][m][1];
                const float eb = -1.4426950408889634f * rs, ik2 = __builtin_amdgcn_rcpf(rs * rs * (F8OUT ? (float)(1 << F8S_HID) : 1.0f));
                float h[8];
#pragma unroll
                for (int j = 0; j < 4; j += 2) {
                    { const f32x2 G = {g0[j], g0[j + 1]}, U = {u0[j], u0[j + 1]}; const f32x2 T = G * eb; f32x2 D = {__builtin_amdgcn_exp2f(T[0]), __builtin_amdgcn_exp2f(T[1])}; D = D * ik2 + ik2;
                      const f32x2 R = {__builtin_amdgcn_rcpf(D[0]), __builtin_amdgcn_rcpf(D[1])}; const f32x2 H = (G * U) * R; h[j] = H[0]; h[j + 1] = H[1]; }
                    { const f32x2 G = {g1[j], g1[j + 1]}, U = {u1[j], u1[j + 1]}; const f32x2 T = G * eb; f32x2 D = {__builtin_amdgcn_exp2f(T[0]), __builtin_amdgcn_exp2f(T[1])}; D = D * ik2 + ik2;
                      const f32x2 R = {__builtin_amdgcn_rcpf(D[0]), __builtin_amdgcn_rcpf(D[1])}; const f32x2 H = (G * U) * R; h[4 + j] = H[0]; h[4 + j + 1] = H[1]; } }
                const int lrow = wr * 64 + fr + ai * HALF + m * 16;
                if (F8OUT) { u32x2 w; w.x = cvt_pk4_fp8(h[0], h[1], h[2], h[3]); w.y = cvt_pk4_fp8(h[4], h[5], h[6], h[7]);
                    *(u32x2*)((unsigned char*)H + (((size_t)u.pm * (DFF / 128) + u.pn) * 256 + lrow) * 128 + wc * 32 + 8 * fq) = w; }
                else { u32x4 w; w.x = cvt_pk_bf16(h[0], h[1]); w.y = cvt_pk_bf16(h[2], h[3]); w.z = cvt_pk_bf16(h[4], h[5]); w.w = cvt_pk_bf16(h[6], h[7]);
                    *(u32x4*)((unsigned char*)H + (((size_t)u.pm * (DFF / 64) + 2 * u.pn + (wc >> 1)) * 256 + lrow) * 128 + (wc & 1) * 64 + 16 * fq) = w; } }
    }
};
struct EpiWin {
    static constexpr bool PERM = true; static constexpr int RSMODE = 1;
    bf16_t* GY; bf16_t* XBR;
    __device__ __forceinline__ void operator()(const f32x4 (&acc)[2][2][4][2], const Unit& u, int wr, int wc, int fr, int fq, const LAS unsigned char* rsl) const {
        const bool isy = u.pn < 4; bf16_t* O = isy ? GY : XBR;
        const int r0 = u.pm * BM + wr * 64 + fr, c0 = (u.pn & 3) * BM + wc * 32 + 8 * fq;
#pragma unroll
        for (int ai = 0; ai < 2; ++ai)
#pragma unroll
            for (int m = 0; m < 4; ++m) { const float rs = rs_lds(rsl, 1, wr * 64 + fr + ai * HALF + m * 16);
#pragma unroll
                for (int bj = 0; bj < 2; ++bj) { f32x4 v0 = acc[ai][bj][m][0] * rs, v1 = acc[ai][bj][m][1] * rs;
                    if (isy) {
                        constexpr float c1 = -2.0f * 0.7978845608028654f * 1.4426950408889634f, c2 = c1 * 0.044715f;
#pragma unroll
                        for (int j = 0; j < 4; j += 2) {
                            { const f32x2 X = {v0[j], v0[j + 1]}; const f32x2 T = X * ((X * X) * c2 + c1); const f32x2 D = (f32x2){__builtin_amdgcn_exp2f(T[0]), __builtin_amdgcn_exp2f(T[1])} + 1.0f;
                              const f32x2 Y = X * (f32x2){__builtin_amdgcn_rcpf(D[0]), __builtin_amdgcn_rcpf(D[1])}; v0[j] = Y[0]; v0[j + 1] = Y[1]; }
                            { const f32x2 X = {v1[j], v1[j + 1]}; const f32x2 T = X * ((X * X) * c2 + c1); const f32x2 D = (f32x2){__builtin_amdgcn_exp2f(T[0]), __builtin_amdgcn_exp2f(T[1])} + 1.0f;
                              const f32x2 Y = X * (f32x2){__builtin_amdgcn_rcpf(D[0]), __builtin_amdgcn_rcpf(D[1])}; v1[j] = Y[0]; v1[j + 1] = Y[1]; } } }
                    u32x4 w; w.x = cvt_pk_bf16(v0[0], v0[1]); w.y = cvt_pk_bf16(v0[2], v0[3]); w.z = cvt_pk_bf16(v1[0], v1[1]); w.w = cvt_pk_bf16(v1[2], v1[3]);
                    *(u32x4*)(O + (size_t)(r0 + ai * HALF + m * 16) * DM + c0 + bj * HALF) = w; } }
    }
};
struct EpiBf16 {
    static constexpr bool PERM = true; static constexpr int RSMODE = 1;
    bf16_t* O; int ldc;
    __device__ __forceinline__ void operator()(const f32x4 (&acc)[2][2][4][2], const Unit& u, int wr, int wc, int fr, int fq, const LAS unsigned char* rsl) const {
        const int r0 = u.pm * BM + wr * 64 + fr, c0 = u.pn * BM + wc * 32 + 8 * fq;
#pragma unroll
        for (int ai = 0; ai < 2; ++ai)
#pragma unroll
            for (int m = 0; m < 4; ++m) { const float rs0 = rs_lds(rsl, 1, wr * 64 + fr + ai * HALF + m * 16), rs = ldc < 0 ? rs0 * 4.f : rs0;
#pragma unroll
                for (int bj = 0; bj < 2; ++bj) { const f32x4 v0 = acc[ai][bj][m][0] * rs, v1 = acc[ai][bj][m][1] * rs;
                    if (ldc < 0) { u32x2 q; q.x = cvt_pk4_fp8(v0[0], v0[1], v0[2], v0[3]); q.y = cvt_pk4_fp8(v1[0], v1[1], v1[2], v1[3]);
                        *(u32x2*)((unsigned char*)O + (size_t)(r0 + ai * HALF + m * 16) * (size_t)(-ldc) + c0 + bj * HALF) = q; }
                    else { u32x4 w; w.x = cvt_pk_bf16(v0[0], v0[1]); w.y = cvt_pk_bf16(v0[2], v0[3]); w.z = cvt_pk_bf16(v1[0], v1[1]); w.w = cvt_pk_bf16(v1[2], v1[3]);
                        *(u32x4*)(O + (size_t)(r0 + ai * HALF + m * 16) * ldc + c0 + bj * HALF) = w; } } }
    }
};

#if PROBE_EPI
template <int RSM> struct EpiNull {
    static constexpr bool PERM = true; static constexpr int RSMODE = RSM;
    __device__ __forceinline__ void operator()(const f32x4 (&acc)[2][2][4][2], const Unit&, int, int, int, int, const LAS unsigned char*) const {
#pragma unroll
        for (int a = 0; a < 2; ++a)
#pragma unroll
            for (int b = 0; b < 2; ++b)
#pragma unroll
                for (int m = 0; m < 4; ++m)
#pragma unroll
                    for (int n = 0; n < 2; ++n) asm volatile("" :: "v"(acc[a][b][m][n]));
    }
};
#endif
template <class Epi, bool GATHER, int F8SW = 0, int F8SA = 0>
__device__ __forceinline__ void gemm_phase(LAS unsigned char* lds, const int K, const Sched& S, const Epi& E, int wv) {
    constexpr bool FP8 = F8SW != 0; constexpr int ES = FP8 ? 1 : 2;
    const int tid = fresh_tid(wv), wid = __builtin_amdgcn_readfirstlane(tid >> 6), lane = tid & 63, wr = wid >> 2, wc = wid & 3, fr = lane & 15, fq = lane >> 4;
    const int nt = K / (FP8 ? 2 * BK : BK);
    unsigned voffB[2];
#pragma unroll
    for (int i = 0; i < 2; ++i) { int R, C; stage_rc(tid * 16 + i * 8192, R, C); const int Rb = Epi::PERM ? ((R & ~31) + perm32(R & 31)) : R; voffB[i] = (unsigned)(Rb * K * ES + C * 2); }
    const size_t kstep = (size_t)(BK * 2);
    const size_t hstep = (size_t)HALF * K * ES;
    const size_t tstep = 2 * hstep;
    const bool atm = !GATHER && S.a_tm != 0;
    const int arow = atm ? 128 : K * ES;
    const size_t kstepA = atm ? (size_t)32768 : kstep, hstepA = (size_t)HALF * arow, tstepA = atm ? (size_t)nt * 32768 : tstep;
    const unsigned ldsw = (unsigned)wid * 1024u;
    const int aoff = lds_byte(wr * 64 + fr, fq * 8), boff = lds_byte(wc * 32 + fr, fq * 8);
    unsigned voffA[2][2];
#define PG8_SETV(V, U) do { _Pragma("unroll") for (int _h = 0; _h < (GATHER ? 2 : 1); ++_h) _Pragma("unroll") for (int _i = 0; _i < 2; ++_i) { int _R, _C; stage_rc((fresh_tid(wv)) * 16 + _i * 8192, _R, _C); \
        if (GATHER) { int _g = S.gidx[(size_t)(S.t0 + ((PROBE_EPI == 4 || PROBE_EPI == 5) && S.hot ? 0 : (U).pm)) * BM + _h * HALF + _R]; _g = _g < 0 ? 0 : (_g & 0xFFFFF); V[_h][_i] = (unsigned)_g * (unsigned)(K * ES) + (unsigned)(_C * 2); } \
        else V[_h][_i] = (unsigned)(_R * arow + _C * 2); } } while (0)
#define PG8_ABASE(U) (GATHER ? S.A : S.A + (size_t)((PROBE_EPI == 4 || PROBE_EPI == 5) && S.hot ? 0 : (U).pm) * tstepA)
#define PG8_BBASE(U) (S.B + (size_t)(U).e * S.b_estride + (size_t)((PROBE_EPI == 4 || PROBE_EPI == 5) && S.hot ? 0 : (U).pn) * tstep)
#define PG8_SA(b, h) (((b) * 2 + (h)) * HTB)
#define PG8_SB(b, h) ((4 + (b) * 2 + (h)) * HTB)
#define PG8_STAGE(bufoff, gbase, voff) do { _Pragma("unroll") for (int _i = 0; _i < 2; ++_i) \
        __builtin_amdgcn_global_load_lds((const unsigned*)((const char*)(gbase) + (voff)[_i]), (LAS unsigned*)(lds + (bufoff) + ldsw + _i * 8192), 16, 0, 0); } while (0)
#define PG8_STAGE_A(bufoff, gbase, h) do { if (GATHER) PG8_STAGE(bufoff, gbase, voffA[h]); else PG8_STAGE(bufoff, (gbase) + (h) * hstepA, voffA[0]); } while (0)
#define PG8_LDA(dst, b, h) do { _Pragma("unroll") for (int m = 0; m < 4; ++m) _Pragma("unroll") for (int k = 0; k < 2; ++k) dst[m][k] = *(const LAS bf16x8*)(lds + PG8_SA(b, h) + aoff + m * 2048 + k * 1024); } while (0)
#define PG8_LDB(dst, b, h) do { _Pragma("unroll") for (int n = 0; n < 2; ++n) _Pragma("unroll") for (int k = 0; k < 2; ++k) dst[n][k] = *(const LAS bf16x8*)(lds + PG8_SB(b, h) + boff + n * 2048 + k * 1024); } while (0)
#define PG8_CAT(X) __builtin_shufflevector(__builtin_bit_cast(i32x4, (X)[0]), __builtin_bit_cast(i32x4, (X)[1]), 0, 1, 2, 3, 4, 5, 6, 7)
#define PG8_MMA(ai, bj, At, Bt) do { __builtin_amdgcn_s_setprio(1); \
        if (FP8) { _Pragma("unroll") for (int m = 0; m < 4; ++m) _Pragma("unroll") for (int n = 0; n < 2; ++n) \
            asm volatile("v_mfma_scale_f32_16x16x128_f8f6f4 %0, %1, %2, %0, %3, %4 op_sel_hi:[0,0,0]" : "+v"(acc[ai][bj][m][n]) : "v"(PG8_CAT(Bt[n])), "v"(PG8_CAT(At[m])), "v"(f8sw), "v"(f8sa)); } \
        else { _Pragma("unroll") for (int m = 0; m < 4; ++m) _Pragma("unroll") for (int n = 0; n < 2; ++n) _Pragma("unroll") for (int k = 0; k < 2; ++k) \
            acc[ai][bj][m][n] = __builtin_amdgcn_mfma_f32_16x16x32_bf16(Bt[n][k], At[m][k], acc[ai][bj][m][n], 0, 0, 0); } \
        __builtin_amdgcn_s_setprio(0); } while (0)
#define PG8_WAIT_V(n) asm volatile("s_waitcnt vmcnt(" #n ")" ::: "memory")
#define PG8_WAIT_L(n) asm volatile("s_waitcnt lgkmcnt(" #n ")" ::: "memory")
#define PG8_BAR __builtin_amdgcn_s_barrier()
#define PG8_SCHED __builtin_amdgcn_sched_barrier(0)
    int tb0 = 0x7fffffff, tb1 = 0x7fffffff, tb2 = 0x7fffffff, tb3 = 0x7fffffff, tb4 = 0x7fffffff, tb5 = 0x7fffffff, tb6 = 0x7fffffff;
    if (S.tile_e) { tb0 = __builtin_amdgcn_readfirstlane(S.tile_e[1]) >> 8; tb1 = __builtin_amdgcn_readfirstlane(S.tile_e[2]) >> 8; tb2 = __builtin_amdgcn_readfirstlane(S.tile_e[3]) >> 8; tb3 = __builtin_amdgcn_readfirstlane(S.tile_e[4]) >> 8;
        tb4 = __builtin_amdgcn_readfirstlane(S.tile_e[5]) >> 8; tb5 = __builtin_amdgcn_readfirstlane(S.tile_e[6]) >> 8; tb6 = __builtin_amdgcn_readfirstlane(S.tile_e[7]) >> 8; }
#define PG8_EXPERT(U) do { const int _t = S.t0 + (U).pm; (U).e = __builtin_amdgcn_readfirstlane((_t >= tb0) + (_t >= tb1) + (_t >= tb2) + (_t >= tb3) + (_t >= tb4) + (_t >= tb5) + (_t >= tb6)); } while (0)
    const int kmask = (K_ROT && (nt & (nt - 1)) == 0) ? nt - 1 : 0x7fffffff;
    const int rot = (K_ROT && (nt & (nt - 1)) == 0) ? ((__builtin_amdgcn_readfirstlane(S.c >> 3) * 2) & kmask) : 0;
#define PG8_KT(i) (((i) + rot) & kmask)
    Unit cur, nxt; int ui = 0;
    if (!S.next(0, cur)) return;
    PG8_EXPERT(cur);
    if (GEMM_STAGGER) { const int dly = (S.c & 7) * GEMM_STAGGER; for (int i = 0; i < dly; ++i) __builtin_amdgcn_s_sleep(8); }
    const int f8sw = F8SW, f8sa = F8SA;
    f32x4 acc[2][2][4][2];
#pragma unroll
    for (int a = 0; a < 2; ++a)
#pragma unroll
        for (int b = 0; b < 2; ++b)
#pragma unroll
            for (int m = 0; m < 4; ++m)
#pragma unroll
                for (int n = 0; n < 2; ++n) acc[a][b][m][n] = (f32x4){0.f, 0.f, 0.f, 0.f};
    bf16x8 At[4][2], B0[2][2], B1[2][2];
    const char* cA = PG8_ABASE(cur); const char* cB = PG8_BBASE(cur);
    constexpr int RSM = Epi::RSMODE;
#define PG8_RSDMA(U) do { if (RSM == 1) { _Pragma("unroll") for (int _i = 0; _i < 2; ++_i) __builtin_amdgcn_global_load_lds((const unsigned*)(S.rs + (size_t)(U).pm * 16384 + (unsigned)(fresh_tid(wv) * 16 + _i * 8192)), (LAS unsigned*)(lds + LDS_RSL + ldsw + _i * 8192), 16, 0, 0); } \
        else if (RSM == 2) { if (wid < 4) __builtin_amdgcn_global_load_lds((const unsigned*)(S.rs + (size_t)(S.t0 + (U).pm) * 1024 + (unsigned)(fresh_tid(wv) * 4)), (LAS unsigned*)(lds + LDS_RSL + ldsw / 4), 4, 0, 0); } \
        else if (RSM == 3) { __builtin_amdgcn_global_load_lds((const unsigned*)((wid < 4 ? S.rs : S.rs2) + (size_t)(S.t0 + (U).pm) * 1024 + (unsigned)((fresh_tid(wv) & 255) * 4)), (LAS unsigned*)(lds + LDS_RSL + ldsw / 4), 4, 0, 0); } } while (0)
#pragma unroll
    for (int h = 0; h < 2; ++h) { voffA[h][0] = 0u; voffA[h][1] = 0u; }
    PG8_SETV(voffA, cur);
    if (GATHER) { asm volatile("s_waitcnt vmcnt(0)" ::: "memory"); }
    { const char* pA = cA + (size_t)rot * kstepA; const char* pB = cB + (size_t)rot * kstep;
    PG8_STAGE(PG8_SB(0, 0), pB, voffB); PG8_STAGE_A(PG8_SA(0, 0), pA, 0); PG8_STAGE(PG8_SB(0, 1), pB + hstep, voffB); PG8_STAGE_A(PG8_SA(0, 1), pA, 1);
    if (wr == 1) PG8_BAR;
    PG8_WAIT_V(4); PG8_BAR;
    PG8_STAGE(PG8_SB(1, 0), pB + kstep, voffB); PG8_STAGE_A(PG8_SA(1, 0), pA + kstepA, 0); PG8_STAGE(PG8_SB(1, 1), pB + hstep + kstep, voffB); }
    PG8_WAIT_V(6); PG8_BAR;
    for (;;) {
        const bool has_next = S.next(ui + 1, nxt);
        if (has_next) PG8_EXPERT(nxt);
        const char* nA = has_next ? PG8_ABASE(nxt) : cA; const char* nB = has_next ? PG8_BBASE(nxt) : cB;
#pragma unroll 1
        for (int t = 0; t < nt; t += 2) {
            const bool last = (t == nt - 2);
            const char* a1 = cA + (size_t)(PG8_KT(t) + 1) * kstepA;
            const char* a2 = last ? nA + (size_t)rot * kstepA : cA + (size_t)PG8_KT(t + 2) * kstepA; const char* b2 = last ? nB + (size_t)rot * kstep : cB + (size_t)PG8_KT(t + 2) * kstep;
            const char* a3 = a2 + kstepA; const char* b3 = b2 + kstep;
            asm volatile("" : "+s"(a1), "+s"(a2), "+s"(a3), "+s"(b2), "+s"(b3));
            PG8_LDB(B0, 0, 0); PG8_SCHED; PG8_LDA(At, 0, 0); PG8_STAGE_A(PG8_SA(1, 1), a1, 1);
            if (GATHER) { if (last && has_next) { _Pragma("unroll") for (int _h = 0; _h < 2; ++_h) _Pragma("unroll") for (int _i = 0; _i < 2; ++_i) { int _R, _C; stage_rc((fresh_tid(wv)) * 16 + _i * 8192, _R, _C);
                    int _g = *(const LAS int*)(lds + LDS_GIX + (_h * HALF + _R) * 4); _g = _g < 0 ? 0 : (_g & 0xFFFFF); voffA[_h][_i] = (unsigned)_g * (unsigned)(K * ES) + (unsigned)(_C * 2); } } }
            PG8_WAIT_L(8); PG8_BAR; PG8_WAIT_L(0); PG8_MMA(0, 0, At, B0); PG8_BAR; PG8_SCHED;
            PG8_LDB(B1, 0, 1); PG8_STAGE(PG8_SB(0, 0), b2, voffB);
            PG8_BAR; PG8_WAIT_L(0); PG8_MMA(0, 1, At, B1); PG8_BAR;
            PG8_LDA(At, 0, 1); PG8_STAGE_A(PG8_SA(0, 0), a2, 0);
            if (RSM != 0) { if (t == 0) PG8_RSDMA(cur); }
            if (GATHER) { if (t == 0 && has_next && wid < 4) __builtin_amdgcn_global_load_lds((const unsigned*)(S.gidx + (size_t)(S.t0 + ((PROBE_EPI == 4 || PROBE_EPI == 5) && S.hot ? 0 : nxt.pm)) * BM + fresh_tid(wv)), (LAS unsigned*)(lds + LDS_GIX + ldsw / 4), 4, 0, 0); }
            PG8_BAR; PG8_WAIT_L(0); PG8_MMA(1, 0, At, B0); PG8_BAR; PG8_SCHED;
            PG8_STAGE(PG8_SB(0, 1), b2 + hstep, voffB);
            if (RSM == 1) { if (t == 2 && wid < 4) rs_reduce_lds(lds + LDS_RSL, fresh_tid(wv)); }
            PG8_WAIT_V(6); PG8_BAR; PG8_MMA(1, 1, At, B1); PG8_BAR;
            PG8_LDB(B0, 1, 0); PG8_SCHED; PG8_LDA(At, 1, 0); PG8_STAGE_A(PG8_SA(0, 1), a2, 1);
            PG8_WAIT_L(8); PG8_BAR; PG8_WAIT_L(0); PG8_MMA(0, 0, At, B0); PG8_BAR; PG8_SCHED;
            PG8_LDB(B1, 1, 1); PG8_STAGE(PG8_SB(1, 0), b3, voffB);
            PG8_BAR; PG8_WAIT_L(0); PG8_MMA(0, 1, At, B1); PG8_BAR;
            PG8_LDA(At, 1, 1); PG8_STAGE_A(PG8_SA(1, 0), a3, 0);
            PG8_BAR; PG8_WAIT_L(0); PG8_MMA(1, 0, At, B0); PG8_BAR; PG8_SCHED;
            PG8_STAGE(PG8_SB(1, 1), b3 + hstep, voffB);
            PG8_WAIT_V(6); PG8_BAR; PG8_MMA(1, 1, At, B1); PG8_BAR;
        }
        if (FP8) asm volatile("s_nop 15\n\ts_nop 15" ::: "memory");
        { const int l2 = lane_id(); E(acc, cur, wr, wc, l2 & 15, l2 >> 4, lds + LDS_RSL); }
        if (!has_next) break;
#pragma unroll
        for (int a = 0; a < 2; ++a)
#pragma unroll
            for (int b = 0; b < 2; ++b)
#pragma unroll
                for (int m = 0; m < 4; ++m)
#pragma unroll
                    for (int n = 0; n < 2; ++n) acc[a][b][m][n] = (f32x4){0.f, 0.f, 0.f, 0.f};
        cur = nxt; cA = nA; cB = nB; ++ui;
    }
    PG8_WAIT_V(0);
    if (wr == 0) PG8_BAR;
    PG8_BAR;
#undef PG8_STAGE_A
#undef PG8_EXPERT
#undef PG8_KT
#undef PG8_RSDMA
#undef PG8_SETV
#undef PG8_ABASE
#undef PG8_BBASE
#undef PG8_SA
#undef PG8_SB
#undef PG8_STAGE
#undef PG8_LDA
#undef PG8_LDB
#undef PG8_MMA
#undef PG8_CAT
#undef PG8_WAIT_V
#undef PG8_WAIT_L
#undef PG8_BAR
#undef PG8_SCHED
}
}

__device__ __forceinline__ void transpose_load(const float* W, int N, int item, int lane, float (&wv_)[32]) {
    const int nblk = N / 32, kb = item / nblk, nb = item % nblk, k0 = 64 * kb, n0 = 32 * nb;
#pragma unroll
    for (int i = 0; i < 8; ++i) { const int kk = 8 * i + (lane >> 3); const f32x4 v = __builtin_nontemporal_load((const f32x4*)(W + (size_t)(k0 + kk) * N + n0 + 4 * (lane & 7)));
        wv_[4 * i] = v[0]; wv_[4 * i + 1] = v[1]; wv_[4 * i + 2] = v[2]; wv_[4 * i + 3] = v[3]; }
}
template <int F8S = -1>
__device__ __forceinline__ void transpose_item(const float (&wv_)[32], int K, int N, bf16_t* WT, int mode, LAS float* scr, int item, int lane, const float* gain) {
    const int nblk = N / 32, kb = item / nblk, nb = item % nblk, k0 = 64 * kb, n0 = 32 * nb;
    const float gl = gain ? gain[k0 + lane] : 1.0f;
#pragma unroll
    for (int i = 0; i < 8; ++i) { const int kk = 8 * i + (lane >> 3); LAS float* d = scr + kk * 33 + 4 * (lane & 7);
        if (gain) { const float g = __int_as_float(__builtin_amdgcn_ds_bpermute(kk * 4, __float_as_int(gl))); d[0] = wv_[4 * i] * g; d[1] = wv_[4 * i + 1] * g; d[2] = wv_[4 * i + 2] * g; d[3] = wv_[4 * i + 3] * g; }
        else { d[0] = wv_[4 * i]; d[1] = wv_[4 * i + 1]; d[2] = wv_[4 * i + 2]; d[3] = wv_[4 * i + 3]; } }
    asm volatile("s_waitcnt lgkmcnt(0)" ::: "memory");
    int d0 = n0;
    if (mode == 1) { d0 = (n0 < DFF) ? ((n0 >> 7) * 256 + (n0 & 127)) : (((n0 - DFF) >> 7) * 256 + 128 + ((n0 - DFF) & 127)); }
    const int c = lane & 7;
#pragma unroll
    for (int j = 0; j < 4; ++j) { const int n = (lane >> 3) + 8 * j; const LAS float* s = scr + (8 * c) * 33 + n;
        if (F8S >= 0) { constexpr float sc = (float)(1 << (F8S < 0 ? 0 : F8S)); u32x2 o; o.x = cvt_pk4_fp8(s[0 * 33] * sc, s[1 * 33] * sc, s[2 * 33] * sc, s[3 * 33] * sc); o.y = cvt_pk4_fp8(s[4 * 33] * sc, s[5 * 33] * sc, s[6 * 33] * sc, s[7 * 33] * sc);
            *(u32x2*)((unsigned char*)WT + (size_t)(d0 + n) * K + k0 + 8 * c) = o; }
        else { u32x4 o; o.x = cvt_pk_bf16(s[0 * 33], s[1 * 33]); o.y = cvt_pk_bf16(s[2 * 33], s[3 * 33]); o.z = cvt_pk_bf16(s[4 * 33], s[5 * 33]); o.w = cvt_pk_bf16(s[6 * 33], s[7 * 33]);
            *(u32x4*)(WT + (size_t)(d0 + n) * K + k0 + 8 * c) = o; } }
    asm volatile("s_waitcnt lgkmcnt(0)" ::: "memory");
}

struct Params { const float* in[47]; float* out; unsigned char* ws; int lo, hi; };

__device__ __forceinline__ void prologue_phase(const Params& p, LAS unsigned char* lds, int G, int c, int wv) {
    const int tid = fresh_tid(wv), lane = tid & 63, wave = __builtin_amdgcn_readfirstlane(tid >> 6);
    LAS float* scr = (LAS float*)(lds + wave * 8448);
    bf16_t* WB = (bf16_t*)(p.ws + WS_WB);
    const int gw = c * 8 + wave, NGW = G * 8;
#define CVT_ONE(IN, KK, NN, MODE, NE, OFF, F8S, GIN) do { const int per = ((KK) / 64) * ((NN) / 32), tot = per * (NE); const float* src = p.in[IN]; bf16_t* dst = WB + (OFF); const float* gn = (GIN) >= 0 ? p.in[(GIN) < 0 ? 0 : (GIN)] : nullptr; \
        float ra[32]; if (gw < tot) { const int e = gw / per, r = gw - e * per; transpose_load(src + (size_t)e * (KK) * (NN), (NN), r, lane, ra); } \
        _Pragma("unroll 1") for (int it = gw; it < tot; it += NGW) { const int e = it / per, r = it - e * per; float rb[32]; const int nx = it + NGW; \
            if (nx < tot) { const int e2 = nx / per, r2 = nx - e2 * per; transpose_load(src + (size_t)e2 * (KK) * (NN), (NN), r2, lane, rb); }     \
            transpose_item<F8S>(ra, (KK), (NN), dst + (size_t)e * (KK) * (NN), (MODE), scr, r, lane, gn); \
            if (nx < tot) { _Pragma("unroll") for (int i_ = 0; i_ < 32; ++i_) ra[i_] = rb[i_]; } } } while (0)
#define SGU(L) (F8GU(L) ? F8S_WGU : -1)
#define SDN(L) (F8DN(L) ? F8S_WD : -1)
    CVT_ONE(2, 1024, 2048, 0, 1, O_L0_WIN, (((FP8_WIN) & 1) ? F8S_WGU : -1), 1); CVT_ONE(10, 1024, 1024, 0, 1, O_L0_WOUT, (((FP8_RES) & 1) ? F8S_WGU : -1), -1); CVT_ONE(12, 1024, 7168, 1, 1, O_L0_WGU, SGU(0), 11); CVT_ONE(13, 3584, 1024, 0, 1, O_L0_WD, SDN(0), -1);
    CVT_ONE(15, 1024, 1536, 0, 1, O_L1_QKV, (FP8_QKV1 ? F8S_WGU : -1), 14); CVT_ONE(18, 1024, 1024, 0, 1, O_L1_WOUT, (((FP8_RES) & 2) ? F8S_WGU : -1), -1); CVT_ONE(22, 1024, 7168, 1, 8, O_L1_WGU, SGU(1), 19); CVT_ONE(23, 3584, 1024, 0, 8, O_L1_WD, SDN(1), -1);
    CVT_ONE(25, 1024, 9216, 0, 1, O_L2_QKV, (FP8_QKV2 ? F8S_WGU : -1), 24); CVT_ONE(28, 1024, 1024, 0, 1, O_L2_WOUT, (((FP8_RES) & 4) ? F8S_WGU : -1), -1); CVT_ONE(30, 1024, 7168, 1, 1, O_L2_WGU, SGU(2), 29); CVT_ONE(31, 3584, 1024, 0, 1, O_L2_WD, SDN(2), -1);
    CVT_ONE(33, 1024, 2048, 0, 1, O_L3_WIN, (((FP8_WIN) & 8) ? F8S_WGU : -1), 32); CVT_ONE(41, 1024, 1024, 0, 1, O_L3_WOUT, (((FP8_RES) & 8) ? F8S_WGU : -1), -1); if (!LATE_CVT) CVT_ONE(45, 1024, 7168, 1, 8, O_L3_WGU, SGU(3), 42); CVT_ONE(46, 3584, 1024, 0, 8, O_L3_WD, SDN(3), -1);
#pragma unroll 1
    for (int L = 0; L < 2; ++L) {
        const float* wa = p.in[L ? 36 : 5]; const float* wx = p.in[L ? 38 : 7]; bf16_t* dst = WB + (L ? O_L3_GATE : O_L0_GATE);
        for (int i = c * 512 + tid; i < (int)E_GATE; i += G * 512) {
            const int cin = i & 127, dout = (i >> 7) & 127, n = (i >> 14) & 7, dir = (i >> 17) & 1, g = i >> 18;
            const float v = (g ? wx : wa)[((size_t)(dir * 8 + n) * 128 + cin) * 128 + dout];
            dst[i] = (bf16_t)(cvt_pk_bf16(-1.4426950408889634f * v, 0.f) & 0xffffu);
        }
    }
    { f32x2* T1 = (f32x2*)(p.ws + WS_T1); f32x2* T2 = (f32x2*)(p.ws + WS_T2);
      for (int i = c * 512 + tid; i < 128 * 32 + SEQ * 16; i += G * 512) { float sn, cs;
          if (i < 128 * 32) { const int pos = i >> 5, j = i & 31; sincosf((float)pos * exp2f(-(float)j * (13.287712379549449f / 32.0f)), &sn, &cs); T1[i] = (f32x2){cs, sn}; }
          else { const int k = i - 128 * 32, pos = k >> 4, j = k & 15; sincosf((float)pos * exp2f(-(float)j * (18.931568569324174f / 16.0f)), &sn, &cs); T2[k] = (f32x2){cs, sn}; } } }
    { bf16_t* XB = (bf16_t*)(p.ws + WS_XB); pg8::ss_t* SS = (pg8::ss_t*)(p.ws + WS_SS); const float* xin = p.in[0];
      for (int rb = gw * 4; rb < MT; rb += NGW * 4) {
          f32x4 xv[4][4];
#pragma unroll
          for (int r = 0; r < 4; ++r)
#pragma unroll
              for (int q = 0; q < 4; ++q) xv[r][q] = __builtin_nontemporal_load(((const f32x4*)(xin + (size_t)(rb + r) * DM) + lane) + 64 * q);
          asm volatile("" ::: "memory");
#pragma unroll
          for (int r = 0; r < 4; ++r) { const int row = rb + r; unsigned long long* o8 = (unsigned long long*)(XB + (size_t)row * DM) + lane; float sq = 0.f;
#pragma unroll
              for (int q = 0; q < 4; ++q) { const f32x4 v = xv[r][q]; sq += (v[0] * v[0] + v[1] * v[1]) + (v[2] * v[2] + v[3] * v[3]);
                  if ((FP8_WIN) & 1) { constexpr float sc = (float)(1 << F8S_HN); ((unsigned*)((unsigned char*)p.out + OUT_X8 + (size_t)row * DM) + lane)[64 * q] = cvt_pk4_fp8(v[0] * sc, v[1] * sc, v[2] * sc, v[3] * sc); }
                  o8[64 * q] = (unsigned long long)cvt_pk_bf16(v[0], v[1]) | ((unsigned long long)cvt_pk_bf16(v[2], v[3]) << 32); }
              sq = wave_sum(sq, lane); if (lane < 16) SS[(size_t)row * 16 + lane] = lane == 0 ? sq : 0.f; } } }
}
__device__ __forceinline__ void late_convert_l3gu(const Params& p, LAS unsigned char* lds, int ncw, int cw, int wv) {
    const int tid = fresh_tid(wv), lane = tid & 63, wave = __builtin_amdgcn_readfirstlane(tid >> 6);
    LAS float* scr = (LAS float*)(lds + wave * 8448);
    bf16_t* WB = (bf16_t*)(p.ws + WS_WB);
    const int gw = cw * 8 + wave, NGW = ncw * 8;
    CVT_ONE(45, 1024, 7168, 1, 8, O_L3_WGU, SGU(3), 42);
}
#undef CVT_ONE
#undef SGU
#undef SDN

template <bool ROUTE, int YMODE, bool F8OUT>
__device__ __forceinline__ void prep_phase(bf16_t* XB, const bf16_t* Y, const pg8::ss_t* ss_in, pg8::ss_t* ss_out, const float* gain, const float* router, const float* rbias, unsigned char* X8, float* outf,
                                           unsigned char* ws, LAS unsigned char* lds, int G, int c, int wv) {
    const int tid = fresh_tid(wv), lane = tid & 63, wave = __builtin_amdgcn_readfirstlane(tid >> 6);
    f32x4 gv[4];
#pragma unroll
    for (int q = 0; q < 4; ++q) gv[q] = ROUTE ? *(const f32x4*)(gain + 4 * lane + 256 * q) : (f32x4){0.f, 0.f, 0.f, 0.f};
    LAS float* RT = (LAS float*)lds;
    LAS int* e1 = (LAS int*)(lds + 32768);
    LAS int* wcnt = (LAS int*)(lds + 32768 + 2048);
    if (ROUTE) {
        for (int i = tid; i < 8192; i += 512) { const int k = i >> 3, e = i & 7; RT[e * 1024 + k] = router[i]; }
        __syncthreads();
    }
    int* TOPE = (int*)(ws + WS_TOPE); float* TOPG = (float*)(ws + WS_TOPG); int* LRANK = (int*)(ws + WS_LRANK); int* TCNT = (int*)(ws + WS_TCNT);
    float rb_[8];
#pragma unroll
    for (int e = 0; e < 8; ++e) rb_[e] = ROUTE ? rbias[e] : 0.f;
    for (int tile = c; tile < MT / 256; tile += G) {
#pragma unroll 1
        for (int i0 = 0; i0 < 32; i0 += 4) {
            u32x2 xv_[4][4], y0_[4][4], y1_[4][4]; float ssum_[4];
#pragma unroll
            for (int r = 0; r < 4; ++r) { const int row = tile * 256 + wave * 32 + i0 + r;
#pragma unroll
                for (int q = 0; q < 4; ++q) { xv_[r][q] = ((const u32x2*)(XB + (size_t)row * DM) + lane)[64 * q];
                    if (YMODE) { y0_[r][q] = *((const u32x2*)(Y + (size_t)row * DM) + lane + 64 * q); y1_[r][q] = *((const u32x2*)(Y + ((size_t)MT + row) * DM) + lane + 64 * q); } }
                ssum_[r] = ROUTE ? pg8::ss_row(ss_in, row) : 0.f; }
            asm volatile("" ::: "memory");
#pragma unroll
            for (int r = 0; r < 4; ++r) {
            const int i = i0 + r, row = tile * 256 + wave * 32 + i;
            f32x4 v[4]; float s = 0.f;
#pragma unroll
            for (int q = 0; q < 4; ++q) { const u32x2 xb = xv_[r][q];
                v[q][0] = __uint_as_float(xb.x << 16); v[q][1] = __uint_as_float(xb.x & 0xffff0000u); v[q][2] = __uint_as_float(xb.y << 16); v[q][3] = __uint_as_float(xb.y & 0xffff0000u);
                if (YMODE) { const u32x2 y0 = y0_[r][q], y1 = y1_[r][q];
                    v[q][0] += __uint_as_float(y0.x << 16) + __uint_as_float(y1.x << 16); v[q][1] += __uint_as_float(y0.x & 0xffff0000u) + __uint_as_float(y1.x & 0xffff0000u);
                    v[q][2] += __uint_as_float(y0.y << 16) + __uint_as_float(y1.y << 16); v[q][3] += __uint_as_float(y0.y & 0xffff0000u) + __uint_as_float(y1.y & 0xffff0000u); }
                if (YMODE == 1) { ((u32x2*)(XB + (size_t)row * DM) + lane)[64 * q] = (u32x2){cvt_pk_bf16(v[q][0], v[q][1]), cvt_pk_bf16(v[q][2], v[q][3])};
                    s += (v[q][0] * v[q][0] + v[q][1] * v[q][1]) + (v[q][2] * v[q][2] + v[q][3] * v[q][3]); }
                if (YMODE == 2) ((f32x4*)(outf + (size_t)row * DM) + lane)[64 * q] = v[q];
                if (F8OUT) { constexpr float sc = (float)(1 << F8S_HN); ((unsigned*)(X8 + (size_t)row * DM) + lane)[64 * q] = cvt_pk4_fp8(v[q][0] * sc, v[q][1] * sc, v[q][2] * sc, v[q][3] * sc); } }
            if (YMODE == 1) { s = wave_sum(s, lane); if (lane < 16) ss_out[(size_t)row * 16 + lane] = lane == 0 ? s : 0.f; }
            if (ROUTE) {
                const float rstd = 1.0f / sqrtf(ssum_[r] * (1.0f / DM) + EPS);
#pragma unroll
                for (int q = 0; q < 4; ++q) v[q] = v[q] * gv[q];
                float lg[8];
                { float pa[8];
#pragma unroll
                  for (int e = 0; e < 8; ++e) { float a = 0.f;
#pragma unroll
                    for (int q = 0; q < 4; ++q) { const f32x4 r4 = *(const LAS f32x4*)(RT + e * 1024 + 4 * lane + 256 * q); a += (v[q][0] * r4[0] + v[q][1] * r4[1]) + (v[q][2] * r4[2] + v[q][3] * r4[3]); }
                    pa[e] = a; }
                  const bool b5 = (lane & 32) != 0, b4 = (lane & 16) != 0, b3 = (lane & 8) != 0;
                  float pb[4], pc[2];
#pragma unroll
                  for (int i = 0; i < 4; ++i) { const float snd = b5 ? pa[i] : pa[i + 4], kp = b5 ? pa[i + 4] : pa[i]; pb[i] = kp + shfl_xor_l(snd, 32, lane); }
#pragma unroll
                  for (int i = 0; i < 2; ++i) { const float snd = b4 ? pb[i] : pb[i + 2], kp = b4 ? pb[i + 2] : pb[i]; pc[i] = kp + shfl_xor_l(snd, 16, lane); }
                  float pd = (b3 ? pc[1] : pc[0]) + shfl_xor_l(b3 ? pc[0] : pc[1], 8, lane);
                  pd += dpp_mov<0xB1>(pd); pd += dpp_mov<0x4E>(pd); pd += dpp_mov<0x141>(pd);
#pragma unroll
                  for (int e = 0; e < 8; ++e) lg[e] = __int_as_float(__builtin_amdgcn_readlane(__float_as_int(pd), 32 * (e >> 2) + 16 * ((e >> 1) & 1) + 8 * (e & 1))) * rstd + rb_[e]; }
                float b1 = lg[0], b2 = -3.0e38f; int i1 = 0, i2 = 0;
#pragma unroll
                for (int e = 1; e < 8; ++e) { if (lg[e] > b1) { b2 = b1; i2 = i1; b1 = lg[e]; i1 = e; } else if (lg[e] > b2) { b2 = lg[e]; i2 = e; } }
                const float g1 = 1.0f / (1.0f + __expf(b2 - b1));
                if (lane == 0) { e1[wave * 32 + i] = i1; e1[256 + wave * 32 + i] = i2; TOPE[(size_t)row * 2] = i1; TOPE[(size_t)row * 2 + 1] = i2; TOPG[(size_t)row * 2] = g1; TOPG[(size_t)row * 2 + 1] = 1.0f - g1; }
            }
            }
        }
        if (ROUTE) {
            __syncthreads();
            const int k = tid >> 8, tl = tid & 255, e = e1[k * 256 + tl]; int rank = 0;
#pragma unroll
            for (int ee = 0; ee < 8; ++ee) { const unsigned long long mk = __ballot(e == ee); if (e == ee) rank = __popcll(mk & ((1ull << lane) - 1ull)); if (lane == 0) wcnt[wave * 8 + ee] = __popcll(mk); }
            __syncthreads();
            int base = 0; const int w0 = k * 4;
            for (int w2 = w0; w2 < wave; ++w2) base += wcnt[w2 * 8 + e];
            LRANK[(size_t)(tile * 256 + tl) * 2 + k] = base + rank;
            if (tid < 16) { const int kk = tid >> 3, ee = tid & 7; TCNT[tile * 16 + tid] = wcnt[(kk * 4 + 0) * 8 + ee] + wcnt[(kk * 4 + 1) * 8 + ee] + wcnt[(kk * 4 + 2) * 8 + ee] + wcnt[(kk * 4 + 3) * 8 + ee]; }
            __syncthreads();
        }
    }
}

__device__ __forceinline__ void moe_scatter_phase(unsigned char* ws, const pg8::ss_t* ss, LAS unsigned char* lds, int G, int c, int wv) {
    const int tid = fresh_tid(wv);
    LAS int* tot = (LAS int*)lds; LAS int* off = tot + 16; LAS int* pre = tot + 32;
    const int* TCNT = (const int*)(ws + WS_TCNT); int* META = (int*)(ws + WS_META);
    const int* TOPE = (const int*)(ws + WS_TOPE); const float* TOPG = (const float*)(ws + WS_TOPG); const int* LRANK = (const int*)(ws + WS_LRANK);
    int* SIDX = (int*)(ws + WS_SIDX); float* SGATE = (float*)(ws + WS_SGATE); float* SRS = (float*)(ws + WS_SRS);
    for (int tile = c; tile < MT / 256; tile += G) {
        const int k = tid >> 8, tl = tid & 255, tok = tile * 256 + tl, e = TOPE[(size_t)tok * 2 + k], lrank = LRANK[(size_t)tok * 2 + k]; const float gate = TOPG[(size_t)tok * 2 + k], rs_tok = pg8::rstd_of(ss, tok);
        { LAS int* cnt = tot + 64; LAS int* seg = cnt + 4096;
          for (int i = tid; i < 4096; i += 512) cnt[i] = TCNT[i];
          __syncthreads();
          if (tid < 128) { const int e = tid & 7, sg = tid >> 3; int t = 0, pr = 0;
#pragma unroll
              for (int j = 0; j < 16; ++j) { const int w = sg * 16 + j; const int v = cnt[w * 16 + e] + cnt[w * 16 + 8 + e]; t += v; pr += (w < tile) ? v : 0; }
              seg[sg * 16 + e] = t; seg[sg * 16 + 8 + e] = pr; }
          __syncthreads();
          if (tid < 8) { int t = 0, pr = 0;
#pragma unroll
              for (int sg = 0; sg < 16; ++sg) { t += seg[sg * 16 + tid]; pr += seg[sg * 16 + 8 + tid]; }
              tot[tid] = t; pre[tid] = pr; pre[8 + tid] = pr + cnt[tile * 16 + tid]; } }
        __syncthreads();
        if (tid == 0) { int o = 0; for (int j = 0; j < 8; ++j) { off[j] = o; o += (tot[j] + 255) & ~255; } off[8] = o; }
        __syncthreads();
        if (tile == 0) {
            if (tid < 9) META[tid] = off[tid];
            if (tid < 8) META[16 + tid] = tot[tid];
            if (tid == 0) META[33] = off[8] >> 8;
            for (int j = 0; j < 8; ++j) { const int t0 = off[j] >> 8, t1 = off[j + 1] >> 8; for (int t = t0 + tid; t < t1; t += 512) META[64 + t] = j;
                for (int r = off[j] + tot[j] + tid; r < off[j + 1]; r += 512) { SIDX[r] = -1; SGATE[r] = 0.f; SRS[r] = 0.f; } }
        }
        const int pos = off[e] + pre[k * 8 + e] + lrank;
        SIDX[pos] = tok | (k << 20); SGATE[pos] = gate; SRS[pos] = rs_tok;
        __syncthreads();
    }
}

constexpr int XC_STRIDE = 272;
constexpr int XT_STRIDE = 68;
constexpr int HS_STRIDE = 132;
constexpr int RG_XT = 64 * XC_STRIDE, RG_HSF = RG_XT + 128 * XT_STRIDE * 4, RG_HSB = RG_HSF + 64 * HS_STRIDE * 4, RG_CW = RG_HSB + 64 * HS_STRIDE * 4;
static_assert(RG_CW + 2560 <= 131072, "RG LDS");
template <int MODE, int DIR>
__device__ __forceinline__ void rg_unit(const LAS unsigned char* XC, const LAS float* XT, LAS float* HSm, const bf16x8 (&wf)[2][8], float ba, float bx, float cc, float& cy, float& pp, int cs, int r32, int hi) {
#pragma unroll
    for (int mi = 0; mi < 2; ++mi) { const int mt = DIR ? 1 - mi : mi;
        f32x16 aa, ax;
#pragma unroll
        for (int r = 0; r < 16; ++r) { aa[r] = ba; ax[r] = bx; }
#pragma unroll
        for (int ks = 0; ks < 8; ++ks) { const bf16x8 xf = *(const LAS bf16x8*)(XC + (32 * mt + r32) * XC_STRIDE + (16 * ks + 8 * hi) * 2);
            aa = __builtin_amdgcn_mfma_f32_32x32x16_bf16(xf, wf[0][ks], aa, 0, 0, 0);
            ax = __builtin_amdgcn_mfma_f32_32x32x16_bf16(xf, wf[1][ks], ax, 0, 0, 0); }
#pragma unroll
        for (int q4 = 0; q4 < 4; ++q4) { const f32x4 xv = *(const LAS f32x4*)(XT + (32 * cs + r32) * XT_STRIDE + 32 * mt + 8 * q4 + 4 * hi);
#pragma unroll
            for (int j = 0; j < 4; ++j) { const int r = 4 * q4 + j;
                const float rg = __builtin_amdgcn_rcpf(1.0f + __builtin_amdgcn_exp2f(aa[r])), ig = __builtin_amdgcn_rcpf(1.0f + __builtin_amdgcn_exp2f(ax[r]));
                const float A = __builtin_amdgcn_exp2f(cc * rg);
                aa[r] = A; ax[r] = __builtin_amdgcn_sqrtf(fmaf(-A, A, 1.0f)) * ig * xv[j]; }
            if (DIR == 0) {
#pragma unroll
                for (int j = 1; j < 4; ++j) { const int r = 4 * q4 + j; ax[r] = fmaf(aa[r], ax[r - 1], ax[r]); aa[r] *= aa[r - 1]; }
            } else {
#pragma unroll
                for (int j = 2; j >= 0; --j) { const int r = 4 * q4 + j; ax[r] = fmaf(aa[r], ax[r + 1], ax[r]); aa[r] *= aa[r + 1]; }
            }
            __builtin_amdgcn_sched_barrier(0); }
#pragma unroll
        for (int qi = 0; qi < 4; ++qi) { const int q4 = DIR ? 3 - qi : qi, rt = 4 * q4 + (DIR ? 0 : 3);
            const float th = ax[rt], tp = aa[rt];
            const float t1 = fmaf(tp, cy, th);
            float c1;
            if (DIR == 0) { auto s1 = __builtin_amdgcn_permlane32_swap(__float_as_uint(cy), __float_as_uint(t1), false, false); c1 = __uint_as_float(s1[0]); }
            else          { auto s1 = __builtin_amdgcn_permlane32_swap(__float_as_uint(t1), __float_as_uint(cy), false, false); c1 = __uint_as_float(s1[1]); }
            const float t2 = fmaf(tp, c1, th);
            { auto s2 = __builtin_amdgcn_permlane32_swap(__float_as_uint(t2), __float_as_uint(t2), false, false); cy = __uint_as_float(DIR ? s2[0] : s2[1]); }
            if (MODE == 0) pp *= tp;
            if (MODE == 1) {
#pragma unroll
                for (int j = 0; j < 4; ++j) { const int r = 4 * q4 + j; HSm[(32 * mt + 8 * q4 + 4 * hi + j) * HS_STRIDE + 32 * cs + r32] = fmaf(aa[r], c1, ax[r]); } }
        }
    }
}
template <int MODE>
__device__ __forceinline__ void rg_phase(const bf16_t* XBR, const bf16_t* GY, bf16_t* RGO, unsigned char* RGO8, const bf16_t* GW, const float* conv_w, const float* conv_b,
                                         const float* b_a, const float* b_x, const float* lam, float* SUMP, float* SUMH, const float* CARRY, LAS unsigned char* lds, int G, int c, int wv) {
    const int tid0 = fresh_tid(wv), lane0 = tid0 & 63, wave = __builtin_amdgcn_readfirstlane(tid0 >> 6);
    const int dir = wave >> 2, cs = wave & 3;
    constexpr float L2E = 1.4426950408889634f;
    LAS unsigned char* XC = lds;
    LAS float* XT = (LAS float*)(lds + RG_XT);
    LAS float* HSm = (LAS float*)(lds + (dir ? RG_HSB : RG_HSF));
    LAS float* CW = (LAS float*)(lds + RG_CW);
    const bool g8 = (G % 8) == 0;
    for (int n = g8 ? c % 8 : 0; n < 8; n += g8 ? 8 : 1) {
        const int jw = g8 ? c / 8 : c, nj = g8 ? G / 8 : G;
        __syncthreads();
        for (int i = tid0; i < 640; i += 512) CW[i] = (i < 512) ? conv_w[(i >> 7) * 1024 + n * 128 + (i & 127)] : conv_b[n * 128 + (i - 512)];
        const char* wb0 = (const char*)(GW + ((size_t)(dir * 8 + n) * 128 + 32 * cs) * 128);
        const char* wb1 = wb0 + (size_t)(2 * 8 * 128 * 128) * 2;
        bf16x8 wf[2][8];
        float ba, bx, cc;
        { const int r32 = lane0 & 31, hi = lane0 >> 5; const unsigned woff0 = (unsigned)(r32 * 128 + 8 * hi) * 2u;
#pragma unroll
          for (int g = 0; g < 2; ++g)
#pragma unroll
              for (int ks = 0; ks < 8; ++ks) wf[g][ks] = *(const bf16x8*)((g ? wb1 : wb0) + (woff0 + (unsigned)(ks * 32)));
          const int chg = dir * 1024 + n * 128 + 32 * cs + r32;
          ba = -L2E * b_a[chg]; bx = -L2E * b_x[chg]; cc = -8.0f * L2E * log1pf(__expf(-lam[chg])); }
        __syncthreads();
        bf16x8 xr[2][4];
#define RG_XLOAD(Q) do { const int _b = (Q) / RG_NCH, _t0 = ((Q) % RG_NCH) * RG_L; int _ln = lane0; asm volatile("" : "+v"(_ln)); \
            _Pragma("unroll") for (int it = 0; it < 2; ++it) _Pragma("unroll") for (int jt = 0; jt < 4; ++jt) { int pos = _t0 + _ln + jt - 2; pos = pos < 0 ? 0 : (pos >= SEQ ? SEQ - 1 : pos);     \
                const char* xb = (const char*)(XBR + (size_t)_b * SEQ * DM + n * 128 + 8 * (wave + 8 * it)); \
                xr[it][jt] = *(const bf16x8*)(xb + (unsigned)pos * (unsigned)(DM * 2)); } } while (0)
        if (jw < NBATCH * RG_NCH) RG_XLOAD(jw);
        bool pend = false; float pend_p = 0.f, pend_h = 0.f; u32x4 pend_o[2] = {}; size_t pend_base = 0;
#define RG_FLUSH() do { if (pend) { if (MODE == 0) { if ((lane0 >> 5) == 0) { SUMP[pend_base + (lane0 & 31)] = pend_p; SUMH[pend_base + (lane0 & 31)] = pend_h; } } \
            else { _Pragma("unroll") for (int it = 0; it < 2; ++it) { const int item = tid0 + 512 * it, tl = item >> 4, c8 = item & 15; \
                if (RGO8) *(u32x2*)(RGO8 + pend_base / 2 + (unsigned)(tl * DM + 8 * c8)) = (u32x2){pend_o[it].x, pend_o[it].y}; else *(u32x4*)((char*)RGO + pend_base + (unsigned)(tl * DM + 8 * c8) * 2u) = pend_o[it]; } } } } while (0)
        for (int q = jw; q < NBATCH * RG_NCH; q += nj) {
            const int b = q / RG_NCH, ch = q % RG_NCH, t0 = ch * RG_L; const size_t row0 = (size_t)b * SEQ + t0;
            int lane_l = lane0; asm volatile("" : "+v"(lane_l));
            const int lane = lane_l, r32 = lane & 31, hi = lane >> 5, tid = (wave << 6) | lane;
            bf16x8 gyv[2];
            float cy = 0.f, pp = 1.f;
            if (MODE == 1) { cy = CARRY[((size_t)(b * RG_NCH + ch) * 2 + dir) * 1024 + n * 128 + 32 * cs + r32];
#pragma unroll
                for (int it = 0; it < 2; ++it) { const int item = tid + 512 * it, tl = item >> 4, c8 = item & 15;
                    gyv[it] = *(const bf16x8*)((const char*)GY + (row0 * DM + n * 128) * 2 + (unsigned)(tl * DM + 8 * c8) * 2u); } }
#pragma unroll
            for (int it = 0; it < 2; ++it) { const int c8 = wave + 8 * it, tl = lane;
                float xc[8];
                { const f32x4 b0 = *(const LAS f32x4*)(CW + 512 + 8 * c8), b1 = *(const LAS f32x4*)(CW + 512 + 8 * c8 + 4);
#pragma unroll
                  for (int j = 0; j < 4; ++j) { xc[j] = b0[j]; xc[4 + j] = b1[j]; } }
#pragma unroll
                for (int jt = 0; jt < 4; ++jt) { const int pos = t0 + tl + jt - 2; const bf16x8 xv = (pos >= 0 && pos < SEQ) ? xr[it][jt] : (bf16x8){0, 0, 0, 0, 0, 0, 0, 0};
                        const f32x4 w0 = *(const LAS f32x4*)(CW + jt * 128 + 8 * c8), w1 = *(const LAS f32x4*)(CW + jt * 128 + 8 * c8 + 4);
#pragma unroll
                        for (int j = 0; j < 4; ++j) { xc[j] += bf2f(xv[j]) * w0[j]; xc[4 + j] += bf2f(xv[4 + j]) * w1[j]; } }
                u32x4 o; o.x = cvt_pk_bf16(xc[0], xc[1]); o.y = cvt_pk_bf16(xc[2], xc[3]); o.z = cvt_pk_bf16(xc[4], xc[5]); o.w = cvt_pk_bf16(xc[6], xc[7]);
                *(LAS u32x4*)(XC + tl * XC_STRIDE + c8 * 16) = o;
#pragma unroll
                for (int j = 0; j < 8; ++j) XT[(8 * c8 + j) * XT_STRIDE + tl] = xc[j]; }
            RG_FLUSH();
            __syncthreads();
            if (MODE == 1) asm volatile("" : "+v"(cy));
            if (q + nj < NBATCH * RG_NCH) RG_XLOAD(q + nj);
            if (dir == 0) rg_unit<MODE, 0>(XC, XT, HSm, wf, ba, bx, cc, cy, pp, cs, r32, hi);
            else          rg_unit<MODE, 1>(XC, XT, HSm, wf, ba, bx, cc, cy, pp, cs, r32, hi);
            if (MODE == 0) {
                { auto s3 = __builtin_amdgcn_permlane32_swap(__float_as_uint(pp), __float_as_uint(pp), false, false); pp = __uint_as_float(s3[0]) * __uint_as_float(s3[1]); }
                pend_base = ((size_t)(b * RG_NCH + ch) * 2 + dir) * 1024 + n * 128 + 32 * cs; pend_p = pp; pend_h = cy; pend = true;
                __syncthreads();
            } else {
                __syncthreads();
                const LAS float* HF = (const LAS float*)(lds + RG_HSF); const LAS float* HB = (const LAS float*)(lds + RG_HSB);
#pragma unroll
                for (int it = 0; it < 2; ++it) { const int item = tid + 512 * it, tl = item >> 4, c8 = item & 15;
                    const f32x4 h0 = *(const LAS f32x4*)(HF + tl * HS_STRIDE + 8 * c8) + *(const LAS f32x4*)(HB + tl * HS_STRIDE + 8 * c8);
                    const f32x4 h1 = *(const LAS f32x4*)(HF + tl * HS_STRIDE + 8 * c8 + 4) + *(const LAS f32x4*)(HB + tl * HS_STRIDE + 8 * c8 + 4);
                    const size_t gob = (row0 * DM + n * 128) * 2; const unsigned gof = (unsigned)(tl * DM + 8 * c8) * 2u;
                    const bf16x8 gy = gyv[it];
                    u32x4 o;
                    if (RGO8) { constexpr float sc = (float)(1 << F8S_AO); o.x = cvt_pk4_fp8(bf2f(gy[0]) * h0[0] * sc, bf2f(gy[1]) * h0[1] * sc, bf2f(gy[2]) * h0[2] * sc, bf2f(gy[3]) * h0[3] * sc);
                        o.y = cvt_pk4_fp8(bf2f(gy[4]) * h1[0] * sc, bf2f(gy[5]) * h1[1] * sc, bf2f(gy[6]) * h1[2] * sc, bf2f(gy[7]) * h1[3] * sc); o.z = 0u; o.w = 0u; }
                    else { o.x = cvt_pk_bf16(bf2f(gy[0]) * h0[0], bf2f(gy[1]) * h0[1]); o.y = cvt_pk_bf16(bf2f(gy[2]) * h0[2], bf2f(gy[3]) * h0[3]);
                    o.z = cvt_pk_bf16(bf2f(gy[4]) * h1[0], bf2f(gy[5]) * h1[1]); o.w = cvt_pk_bf16(bf2f(gy[6]) * h1[2], bf2f(gy[7]) * h1[3]); }
                    (void)gof; pend_o[it] = o; pend_base = gob; }
                pend = true;
            }
        }
        RG_FLUSH();
    }
}
#undef RG_FLUSH
#undef RG_XLOAD
__device__ __forceinline__ void rg_carry_phase(const float* SUMP, const float* SUMH, float* CARRY, LAS unsigned char* lds, int G, int c, int wv) {
    static_assert(RG_NCH == 128, "8 waves x 16 chunks");
    const int tid = fresh_tid(wv), lane = tid & 63, wave = __builtin_amdgcn_readfirstlane(tid >> 6);
    LAS float* XP = (LAS float*)lds; LAS float* XH = XP + 512;
    for (int s0 = c * 64; s0 < NBATCH * 2 * 1024; s0 += G * 64) {
        const int s = s0 + lane, chn = s & 1023, dir = (s >> 10) & 1, b = s >> 11;
        float pv[16], hv[16];
#pragma unroll
        for (int j = 0; j < 16; ++j) { const int i = 16 * wave + j, ch = dir ? RG_NCH - 1 - i : i; const size_t o = ((size_t)(b * RG_NCH + ch) * 2 + dir) * 1024 + chn; pv[j] = SUMP[o]; hv[j] = SUMH[o]; }
        float P = 1.f, H = 0.f;
#pragma unroll
        for (int j = 0; j < 16; ++j) { H = H * pv[j] + hv[j]; P *= pv[j]; }
        XP[wave * 64 + lane] = P; XH[wave * 64 + lane] = H;
        __syncthreads();
        float cy = 0.f;
        for (int w = 0; w < wave; ++w) cy = cy * XP[w * 64 + lane] + XH[w * 64 + lane];
#pragma unroll
        for (int j = 0; j < 16; ++j) { const int i = 16 * wave + j, ch = dir ? RG_NCH - 1 - i : i; const size_t o = ((size_t)(b * RG_NCH + ch) * 2 + dir) * 1024 + chn; CARRY[o] = cy; cy = cy * pv[j] + hv[j]; }
        __syncthreads();
    }
}

template <bool AXIAL>
__device__ __forceinline__ void qknorm_rope_phase(bf16_t* QKV, int nrows, int ld, int vec0, int nvec, const float* qg, const float* kg, int G, int c, int wv, unsigned char* k8 = nullptr) {
    const int tid = fresh_tid(wv), lane = tid & 63, wave = __builtin_amdgcn_readfirstlane(tid >> 6), i16 = lane & 15, grp = lane >> 4;
    float gq[8], gk[8];
#pragma unroll
    for (int k = 0; k < 8; ++k) { gq[k] = qg[8 * i16 + k]; gk[k] = kg[8 * i16 + k]; }
    float fj[8];
#pragma unroll
    for (int k = 0; k < 8; ++k) { if (AXIAL) fj[k] = exp2f(-(float)(8 * (i16 & 3) + k) * (13.287712379549449f / 32.0f)); else fj[k] = exp2f(-(float)(8 * (i16 & 1) + k) * (18.931568569324174f / 16.0f)); }
    const bool rot = AXIAL ? true : (i16 < 4);
    const bool second = AXIAL ? ((i16 >> 2) & 1) : ((i16 >> 1) & 1);
    for (int row = c * 8 + wave; row < nrows; row += G * 8) {
        const int t = row % SEQ;
        const float pos = AXIAL ? (float)((i16 < 8) ? (t >> 6) : (t & 63)) : (float)t;
        float cs_[8], sn_[8];
#pragma unroll
        for (int k = 0; k < 8; ++k) { float s, cc; sincosf(pos * fj[k], &s, &cc); cs_[k] = cc; sn_[k] = s; }
#pragma unroll 1
        for (int v0 = vec0; v0 < nvec; v0 += 4) {
            const int vec = v0 + grp; const bool act = vec < nvec; const int vv = act ? vec : 0;
            int col; bool isq;
            if (AXIAL) { isq = vv < 8; col = isq ? vv * 128 : 1024 + (vv - 8) * 128; }
            else { const int g = vv >> 4, qk = (vv >> 3) & 1, h = vv & 7; isq = qk == 0; col = g * 3072 + qk * 1024 + h * 128; }
            bf16_t* ptr = QKV + (size_t)row * ld + col + 8 * i16;
            const bf16x8 xv = *(const bf16x8*)ptr;
            float y[8]; float ss = 0.f;
#pragma unroll
            for (int k = 0; k < 8; ++k) { y[k] = bf2f(xv[k]); ss += y[k] * y[k]; }
            ss = row16_sum(ss);
            const float rstd = 1.0f / sqrtf(ss * (1.0f / 128.0f) + EPS);
#pragma unroll
            for (int k = 0; k < 8; ++k) y[k] = y[k] * rstd * (isq ? gq[k] : gk[k]);
            float o[8];
#pragma unroll
            for (int k = 0; k < 8; ++k) { const float py = shfl_xor_l(y[k], AXIAL ? 4 : 2, lane);
                o[k] = rot ? (second ? (y[k] * cs_[k] + py * sn_[k]) : (y[k] * cs_[k] - py * sn_[k])) : y[k]; }
            u32x4 w; w.x = cvt_pk_bf16(o[0], o[1]); w.y = cvt_pk_bf16(o[2], o[3]); w.z = cvt_pk_bf16(o[4], o[5]); w.w = cvt_pk_bf16(o[6], o[7]);
            if (AXIAL && k8) { if (act) { const int kvh = vv - 8, b = row / SEQ; u32x2 q8; q8.x = cvt_pk4_fp8(o[0] * 4.f, o[1] * 4.f, o[2] * 4.f, o[3] * 4.f); q8.y = cvt_pk4_fp8(o[4] * 4.f, o[5] * 4.f, o[6] * 4.f, o[7] * 4.f);
                    *(u32x2*)(k8 + ((size_t)(b * 2 + kvh) * SEQ + t) * 128 + 64 * (i16 >> 3) + 32 * (i16 & 1) + 8 * ((i16 >> 1) & 3)) = q8; } }
            else if (act) *(u32x4*)ptr = w;
        }
    }
}

constexpr float ATT_SCALE = 0.088388347648318440f;
constexpr float ATT_THR = 8.f;
#define KSWZ(row, colB) ((row) * 256 + ((colB) ^ (((row) & 7) << 4)))
#define SBAR() __builtin_amdgcn_sched_barrier(0)
__device__ __forceinline__ int crow(int r, int hi) { return (r & 3) + 8 * (r >> 2) + 4 * hi; }
__device__ __forceinline__ void partialSM(f32x16& p0, f32x16& p1, float& m_reg, float& mn, float& alpha) {
    constexpr float C = ATT_SCALE * 1.4426950408889634f;
    float pmax = p0[0];
#pragma unroll
    for (int r = 1; r < 16; ++r) pmax = fmaxf(pmax, p0[r]);
#pragma unroll
    for (int r = 0; r < 16; ++r) pmax = fmaxf(pmax, p1[r]);
    { auto rr = __builtin_amdgcn_permlane32_swap(__float_as_uint(pmax), __float_as_uint(pmax), false, false);
      pmax = fmaxf(__uint_as_float(rr[0]), __uint_as_float(rr[1])); }
    if (__builtin_expect(__all(pmax - m_reg <= ATT_THR / ATT_SCALE), 1)) { mn = m_reg; alpha = 1.f; }
    else { mn = fmaxf(m_reg, pmax); alpha = __builtin_amdgcn_exp2f((m_reg - mn) * C); m_reg = mn; }
    float mnC = -mn * C;
#pragma unroll
    for (int r = 0; r < 16; ++r) p0[r] = fmaf(p0[r], C, mnC);
#pragma unroll
    for (int r = 0; r < 16; ++r) p1[r] = fmaf(p1[r], C, mnC);
#pragma unroll
    for (int r = 0; r < 16; ++r) p0[r] = __builtin_amdgcn_exp2f(p0[r]);
}
#define PK4(P, BASE, OUT) do { unsigned a0 = cvt_pk_bf16(P[BASE + 0], P[BASE + 1]), a1 = cvt_pk_bf16(P[BASE + 2], P[BASE + 3]);   \
    unsigned b0 = cvt_pk_bf16(P[BASE + 4], P[BASE + 5]), b1 = cvt_pk_bf16(P[BASE + 6], P[BASE + 7]);                              \
    auto r0 = __builtin_amdgcn_permlane32_swap(a0, b0, false, false); auto r1 = __builtin_amdgcn_permlane32_swap(a1, b1, false, false); \
    u32x4 w = {r0[0], r1[0], r0[1], r1[1]}; OUT = *reinterpret_cast<bf16x8*>(&w); } while (0)
__device__ __forceinline__ void finishSM(f32x16& p0, f32x16& p1, float alpha, float& l_reg, bf16x8& pa0, bf16x8& pa1, bf16x8& pa2, bf16x8& pa3) {
#pragma unroll
    for (int r = 0; r < 16; ++r) p1[r] = __builtin_amdgcn_exp2f(p1[r]);
    float ps = 0;
#pragma unroll
    for (int r = 0; r < 16; ++r) ps += p0[r];
#pragma unroll
    for (int r = 0; r < 16; ++r) ps += p1[r];
    { auto rr = __builtin_amdgcn_permlane32_swap(__float_as_uint(ps), __float_as_uint(ps), false, false);
      ps = __uint_as_float(rr[0]) + __uint_as_float(rr[1]); }
    l_reg = l_reg * alpha + ps;
    PK4(p0, 0, pa0); PK4(p0, 8, pa1); PK4(p1, 0, pa2); PK4(p1, 8, pa3);
}
__device__ __forceinline__ void qkt(f32x16& p0, f32x16& p1, const char* Ks, const bf16x8* qr, int r32, int hi) {
    p0 = f32x16{}; p1 = f32x16{};
#pragma unroll
    for (int d0 = 0; d0 < 8; ++d0) { int cb = (d0 * 16 + hi * 8) * 2;
        bf16x8 b0 = *reinterpret_cast<const bf16x8*>(Ks + KSWZ(r32, cb));
        bf16x8 b1 = *reinterpret_cast<const bf16x8*>(Ks + KSWZ(32 + r32, cb));
        p0 = __builtin_amdgcn_mfma_f32_32x32x16_bf16(b0, qr[d0], p0, 0, 0, 0);
        p1 = __builtin_amdgcn_mfma_f32_32x32x16_bf16(b1, qr[d0], p1, 0, 0, 0); }
}
__device__ __forceinline__ int v_st(int k, int c) { const int kk = (k & ~0xC) | ((k & 4) << 1) | ((k & 8) >> 1); return ((kk >> 3) * 4 + (c >> 5)) * 512 + ((kk & 7) * 32 + (c & 31)) * 2; }
__device__ __forceinline__ int v_rd_base(int lane) { return ((lane & 3) << 3) | (((lane >> 2) & 3) << 6) | (((lane >> 4) & 1) << 5) | (((lane >> 5) & 1) << 8); }
constexpr int v_rd_off(int d0, int ks, int half) { return d0 * 512 + ks * 4096 + half * 2048; }
template <int OFF> __device__ __forceinline__ s16x4 tr_read(int vb) {
    s16x4 r; asm volatile("ds_read_b64_tr_b16 %0, %1 offset:%2" : "=&v"(r) : "v"(vb), "i"(OFF) : "memory"); return r;
}
#define PKV(L, H) (bf16x8){L[0], L[1], L[2], L[3], H[0], H[1], H[2], H[3]}
template <int D0> __device__ __forceinline__ void pv_one(f32x16& od, int vb, bf16x8 pa0, bf16x8 pa1, bf16x8 pa2, bf16x8 pa3) {
    const s16x4 l0 = tr_read<v_rd_off(D0, 0, 0)>(vb), h0 = tr_read<v_rd_off(D0, 0, 1)>(vb), l1 = tr_read<v_rd_off(D0, 1, 0)>(vb), h1 = tr_read<v_rd_off(D0, 1, 1)>(vb);
    const s16x4 l2 = tr_read<v_rd_off(D0, 2, 0)>(vb), h2 = tr_read<v_rd_off(D0, 2, 1)>(vb), l3 = tr_read<v_rd_off(D0, 3, 0)>(vb), h3 = tr_read<v_rd_off(D0, 3, 1)>(vb);
    asm volatile("s_waitcnt lgkmcnt(0)" ::: "memory"); SBAR();
    od = __builtin_amdgcn_mfma_f32_32x32x16_bf16(pa0, PKV(l0, h0), od, 0, 0, 0);
    od = __builtin_amdgcn_mfma_f32_32x32x16_bf16(pa1, PKV(l1, h1), od, 0, 0, 0);
    od = __builtin_amdgcn_mfma_f32_32x32x16_bf16(pa2, PKV(l2, h2), od, 0, 0, 0);
    od = __builtin_amdgcn_mfma_f32_32x32x16_bf16(pa3, PKV(l3, h3), od, 0, 0, 0);
}
__device__ __forceinline__ void pv_d0(f32x16* o, int vb, bf16x8 pa0, bf16x8 pa1, bf16x8 pa2, bf16x8 pa3) {
    pv_one<0>(o[0], vb, pa0, pa1, pa2, pa3); pv_one<1>(o[1], vb, pa0, pa1, pa2, pa3); pv_one<2>(o[2], vb, pa0, pa1, pa2, pa3); pv_one<3>(o[3], vb, pa0, pa1, pa2, pa3);
}

constexpr int SHM_V = 64 * 128 * 2, SHM_K = 64 * 128 * 2;
template <int LDQ, int LDK, int LDO, bool QFUSE>
__device__ __forceinline__ void attn_dense_body(const bf16_t* __restrict__ Qb, const bf16_t* __restrict__ Kh, const bf16_t* __restrict__ Vh, bf16_t* __restrict__ Ob, int seq, char* lds, int wv,
                                                const float* qg = nullptr, const f32x2* T1 = nullptr, int tq0 = 0) {
    const int tid = fresh_tid(wv), wid = tid >> 6, lane = tid & 63, r32 = lane & 31, hi = lane >> 5;
    char* V_lds = lds; char* K_lds = lds + 2 * SHM_V;
    float* wsp = (float*)(lds + 2 * SHM_V + 2 * SHM_K) + wid * 64; float* li_l = wsp; float* al_l = wsp + 32;
    float m_reg = -1e30f, l_reg = 0; f32x16 o[4] = {}; bf16x8 qr[8];
    const bf16_t* Qw = Qb + (long)(wid * 32 + r32) * LDQ + hi * 8;
#pragma unroll
    for (int d0 = 0; d0 < 8; ++d0) qr[d0] = *(const bf16x8*)(Qw + d0 * 16);
    if (QFUSE) {
        float ss = 0.f;
#pragma unroll
        for (int d0 = 0; d0 < 8; ++d0)
#pragma unroll
            for (int j = 0; j < 8; ++j) { const float x = bf2f(qr[d0][j]); ss += x * x; }
        { auto rr = __builtin_amdgcn_permlane32_swap(__float_as_uint(ss), __float_as_uint(ss), false, false); ss = __uint_as_float(rr[0]) + __uint_as_float(rr[1]); }
        const float rstd = 1.0f / sqrtf(ss * (1.0f / 128.0f) + EPS);
        const int t = tq0 + wid * 32 + r32;
#pragma unroll
        for (int hf = 0; hf < 2; ++hf) { const int pos = hf ? (t & 63) : (t >> 6);
#pragma unroll
            for (int a = 0; a < 2; ++a) { const int d1 = 4 * hf + a, d2 = d1 + 2;
                const f32x4* tp = (const f32x4*)(T1 + pos * 32 + 16 * a + 8 * hi); const f32x4 c01 = tp[0], c23 = tp[1], c45 = tp[2], c67 = tp[3];
                const float cs_[8] = {c01[0], c01[2], c23[0], c23[2], c45[0], c45[2], c67[0], c67[2]}, sn_[8] = {c01[1], c01[3], c23[1], c23[3], c45[1], c45[3], c67[1], c67[3]};
                const f32x4 g1a = *(const f32x4*)(qg + 16 * d1 + 8 * hi), g1b = *(const f32x4*)(qg + 16 * d1 + 8 * hi + 4), g2a = *(const f32x4*)(qg + 16 * d2 + 8 * hi), g2b = *(const f32x4*)(qg + 16 * d2 + 8 * hi + 4);
                float o1[8], o2[8];
#pragma unroll
                for (int j = 0; j < 8; ++j) { const float y1 = bf2f(qr[d1][j]) * rstd * (j < 4 ? g1a[j & 3] : g1b[j & 3]), y2 = bf2f(qr[d2][j]) * rstd * (j < 4 ? g2a[j & 3] : g2b[j & 3]);
                    o1[j] = y1 * cs_[j] - y2 * sn_[j]; o2[j] = y2 * cs_[j] + y1 * sn_[j]; }
                u32x4 w1, w2; w1.x = cvt_pk_bf16(o1[0], o1[1]); w1.y = cvt_pk_bf16(o1[2], o1[3]); w1.z = cvt_pk_bf16(o1[4], o1[5]); w1.w = cvt_pk_bf16(o1[6], o1[7]);
                w2.x = cvt_pk_bf16(o2[0], o2[1]); w2.y = cvt_pk_bf16(o2[2], o2[3]); w2.z = cvt_pk_bf16(o2[4], o2[5]); w2.w = cvt_pk_bf16(o2[6], o2[7]);
                qr[d1] = __builtin_bit_cast(bf16x8, w1); qr[d2] = __builtin_bit_cast(bf16x8, w2); } }
    }
    const int sr = tid >> 4, sc = (tid & 15) * 8, vst0 = v_st(sr, sc), vst1 = v_st(32 + sr, sc);
    const int vb0 = (int)(uintptr_t)V_lds + v_rd_base(lane);
    struct { bf16x8 vs0, vs1, ks0, ks1; } sr_[2];
    const unsigned kvoff = (unsigned)(sr * LDK + sc) * 2u;
#define SLOAD(i, k0) do { const char* _vb = (const char*)Vh + (size_t)(k0) * (LDK * 2); const char* _kb = (const char*)Kh + (size_t)(k0) * (LDK * 2); \
    sr_[i].vs0 = *(const bf16x8*)(_vb + kvoff); sr_[i].vs1 = *(const bf16x8*)(_vb + (size_t)(32 * LDK * 2) + kvoff); \
    sr_[i].ks0 = *(const bf16x8*)(_kb + kvoff); sr_[i].ks1 = *(const bf16x8*)(_kb + (size_t)(32 * LDK * 2) + kvoff); } while (0)
#define SWRITE(b, i) do { *(bf16x8*)(V_lds + (b) * SHM_V + vst0) = sr_[i].vs0;          \
    *(bf16x8*)(V_lds + (b) * SHM_V + vst1) = sr_[i].vs1; int kc = sc * 2;               \
    *(bf16x8*)(K_lds + (b) * SHM_K + KSWZ(sr, kc)) = sr_[i].ks0;                       \
    *(bf16x8*)(K_lds + (b) * SHM_K + KSWZ(32 + sr, kc)) = sr_[i].ks1; } while (0)
#define SWAIT() asm volatile("s_waitcnt vmcnt(4)" ::: "memory")
#define RESC(a) do { if (__any((a) < 1.f)) { if (hi == 0) al_l[r32] = (a); asm volatile("s_waitcnt lgkmcnt(0)" ::: "memory"); \
    _Pragma("unroll") for (int d = 0; d < 4; ++d) _Pragma("unroll") for (int r = 0; r < 16; ++r) o[d][r] *= al_l[crow(r, hi)]; } } while (0)
    f32x16 pA0, pA1, pB0, pB1; float mnA, mnB, alA, alB; bf16x8 pa0, pa1, pa2, pa3; const int NT = seq / 64;
    constexpr int SE = 0, SO = 1;
    SLOAD(SE, 0); asm volatile("s_waitcnt vmcnt(0)" ::: "memory"); SWRITE(0, SE); __syncthreads();
    qkt(pA0, pA1, K_lds, qr, r32, hi); partialSM(pA0, pA1, m_reg, mnA, alA);
    SLOAD(SO, 64); if (2 < NT) SLOAD(SE, 2 * 64);
    SWAIT(); SWRITE(1, SO); __syncthreads();
    for (int j = 1; j + 1 < NT; j += 2) {
        SBAR(); qkt(pB0, pB1, K_lds + SHM_K, qr, r32, hi);
        finishSM(pA0, pA1, alA, l_reg, pa0, pa1, pa2, pa3); SBAR();
        SLOAD(SO, (j + 2) * 64); SBAR();
        pv_d0(o, vb0, pa0, pa1, pa2, pa3); partialSM(pB0, pB1, m_reg, mnB, alB);
        __syncthreads(); SWAIT(); SWRITE(0, SE);
        RESC(alB); __syncthreads();
        SBAR(); qkt(pA0, pA1, K_lds, qr, r32, hi);
        finishSM(pB0, pB1, alB, l_reg, pa0, pa1, pa2, pa3); SBAR();
        if (j + 3 < NT) SLOAD(SE, (j + 3) * 64); SBAR();
        pv_d0(o, vb0 + SHM_V, pa0, pa1, pa2, pa3); partialSM(pA0, pA1, m_reg, mnA, alA);
        __syncthreads(); SWAIT(); SWRITE(1, SO);
        RESC(alA); __syncthreads();
    }
    SBAR(); qkt(pB0, pB1, K_lds + SHM_K, qr, r32, hi);
    finishSM(pA0, pA1, alA, l_reg, pa0, pa1, pa2, pa3); SBAR();
    pv_d0(o, vb0, pa0, pa1, pa2, pa3); partialSM(pB0, pB1, m_reg, mnB, alB);
    __syncthreads(); RESC(alB);
    finishSM(pB0, pB1, alB, l_reg, pa0, pa1, pa2, pa3); SBAR();
    pv_d0(o, vb0 + SHM_V, pa0, pa1, pa2, pa3);
    const int hi_e = lane_id() >> 5;
    if (hi_e == 0) li_l[r32] = l_reg; asm volatile("s_waitcnt lgkmcnt(0)" ::: "memory");
    float rli[16];
#pragma unroll
    for (int r = 0; r < 16; ++r) rli[r] = __builtin_amdgcn_rcpf(li_l[crow(r, hi_e)]);
    bf16_t* Ow = Ob + (long)(wid * 32) * LDO;
#pragma unroll
    for (int r = 0; r < 16; ++r) { int orow = crow(r, hi_e);
#pragma unroll
        for (int d0 = 0; d0 < 4; ++d0) Ow[(long)orow * LDO + d0 * 32 + r32] = (bf16_t)(cvt_pk_bf16(o[d0][r] * rli[r], 0.f) & 0xffffu); }
    __syncthreads();
#undef SLOAD
#undef SWRITE
#undef SWAIT
#undef RESC
}
__device__ __forceinline__ void k8_prepass_phase(const bf16_t* QKV, unsigned char* k8, const float* kg, const f32x2* T1, int G, int c, int wv) {
    const int tid = fresh_tid(wv), lane = tid & 63, wave = __builtin_amdgcn_readfirstlane(tid >> 6), i16 = lane & 15, grp = lane >> 4, kvh = grp & 1;
    float gk[8];
#pragma unroll
    for (int k = 0; k < 8; ++k) gk[k] = kg[8 * i16 + k];
    const bool second = (i16 >> 2) & 1;
    for (int r0 = (c * 8 + wave) * 8; r0 < MT; r0 += G * 64) {
        bf16x8 xv[4]; f32x4 tb[4][4];
#pragma unroll
        for (int st = 0; st < 4; ++st) { const int row = r0 + 2 * st + (grp >> 1), t = row % SEQ, pos = (i16 < 8) ? (t >> 6) : (t & 63);
            xv[st] = *(const bf16x8*)(QKV + (size_t)row * 1536 + 1024 + kvh * 128 + 8 * i16);
            const f32x4* tp = (const f32x4*)(T1 + pos * 32 + 8 * (i16 & 3));
#pragma unroll
            for (int j = 0; j < 4; ++j) tb[st][j] = tp[j]; }
        asm volatile("" ::: "memory");
#pragma unroll
        for (int st = 0; st < 4; ++st) { const int row = r0 + 2 * st + (grp >> 1), t = row % SEQ, b = row / SEQ;
            float y[8]; float ss = 0.f;
#pragma unroll
            for (int k = 0; k < 8; ++k) { y[k] = bf2f(xv[st][k]); ss += y[k] * y[k]; }
            ss = row16_sum(ss);
            const float rstd = 1.0f / sqrtf(ss * (1.0f / 128.0f) + EPS);
#pragma unroll
            for (int k = 0; k < 8; ++k) y[k] = y[k] * rstd * gk[k];
            float o[8];
#pragma unroll
            for (int k = 0; k < 8; ++k) { const float py = shfl_xor_l(y[k], 4, lane); const float cs = tb[st][k >> 1][(k & 1) * 2], sn = tb[st][k >> 1][(k & 1) * 2 + 1];
                o[k] = second ? (y[k] * cs + py * sn) : (y[k] * cs - py * sn); }
            u32x2 q8; q8.x = cvt_pk4_fp8(o[0] * 4.f, o[1] * 4.f, o[2] * 4.f, o[3] * 4.f); q8.y = cvt_pk4_fp8(o[4] * 4.f, o[5] * 4.f, o[6] * 4.f, o[7] * 4.f);
            *(u32x2*)(k8 + ((size_t)(b * 2 + kvh) * SEQ + t) * 128 + 64 * (i16 >> 3) + 32 * (i16 & 1) + 8 * ((i16 >> 1) & 3)) = q8; }
    }
}
__device__ __forceinline__ void vt8_phase(const bf16_t* QKV, unsigned char* VT8, char* lds, int G, int c, int wv) {
    const int tid = fresh_tid(wv);
    constexpr int NU = 16 * (SEQ / 64);
    bf16x8 nx[2];
#define VT8_LOAD(U) do { const int _bk = (U) / (SEQ / 64), _tile = (U) % (SEQ / 64), _b = _bk >> 1, _kvh = _bk & 1; \
        _Pragma("unroll") for (int it = 0; it < 2; ++it) { const int pc = tid + 512 * it, key = pc >> 4, c8 = pc & 15; \
            nx[it] = *(const bf16x8*)(QKV + ((size_t)_b * SEQ + 64 * _tile + key) * 1536 + 1280 + _kvh * 128 + 8 * c8); } } while (0)
    if (c < NU) VT8_LOAD(c);
    for (int u = c; u < NU; u += G) { const int bk = u / (SEQ / 64), tile = u % (SEQ / 64);
#pragma unroll
        for (int it = 0; it < 2; ++it) { const int pc = tid + 512 * it, key = pc >> 4, c8 = pc & 15; *(bf16x8*)(lds + key * 272 + c8 * 16) = nx[it]; }
        if (u + G < NU) VT8_LOAD(u + G);
        __syncthreads();
        { const int col = tid >> 2, part = tid & 3, g = part >> 1, t = part & 1; float v[16];
#pragma unroll
          for (int r = 0; r < 16; ++r) { const int key = 32 * t + (r & 3) + 8 * (r >> 2) + 4 * g; v[r] = 4.f * bf2f(*(const short*)(lds + key * 272 + col * 2)); }
          u32x4 w; w.x = cvt_pk4_fp8(v[0], v[1], v[2], v[3]); w.y = cvt_pk4_fp8(v[4], v[5], v[6], v[7]); w.z = cvt_pk4_fp8(v[8], v[9], v[10], v[11]); w.w = cvt_pk4_fp8(v[12], v[13], v[14], v[15]);
          *(u32x4*)(VT8 + ((size_t)(bk * (SEQ / 64) + tile) * 128 + col) * 64 + part * 16) = w; }
        __syncthreads();
    }
#undef VT8_LOAD
}
constexpr int A8_K = 8192, A8_V = 128 * 80, A8_VOFF = 2 * A8_K, A8_WS = A8_VOFF + 2 * A8_V;
constexpr float A8_THR = 5.f;
__device__ __forceinline__ v8i cat8(u32x4 a, u32x4 b) { return (v8i){(int)a.x, (int)a.y, (int)a.z, (int)a.w, (int)b.x, (int)b.y, (int)b.z, (int)b.w}; }
__device__ __forceinline__ unsigned cvt_pk4_bf8(float a, float b, float c, float d) { int w = 0; w = __builtin_amdgcn_cvt_pk_bf8_f32(a, b, w, false); w = __builtin_amdgcn_cvt_pk_bf8_f32(c, d, w, true); return (unsigned)w; }
typedef short v2s_t __attribute__((ext_vector_type(2)));
__device__ __forceinline__ unsigned cvt_pk4_bf8_sc(float a, float b, float c, float d, float sc) { v2s_t w = {0, 0}; w = __builtin_amdgcn_cvt_scalef32_pk_bf8_f32(w, a, b, sc, false); w = __builtin_amdgcn_cvt_scalef32_pk_bf8_f32(w, c, d, sc, true); return __builtin_bit_cast(unsigned, w); }
template <bool FIRST>
__device__ __forceinline__ void partialSM8(f32x16& p0, f32x16& p1, float& n_reg, float& sc_reg, float& alpha) {
    constexpr float THRL = A8_THR * 1.4426950408889634f;
    float tmax = p0[0];
#pragma unroll
    for (int r = 1; r < 16; ++r) tmax = fmaxf(tmax, p0[r]);
#pragma unroll
    for (int r = 0; r < 16; ++r) tmax = fmaxf(tmax, p1[r]);
    { auto rr = __builtin_amdgcn_permlane32_swap(__float_as_uint(tmax), __float_as_uint(tmax), false, false);
      tmax = fmaxf(__uint_as_float(rr[0]), __uint_as_float(rr[1])); }
    if (!FIRST && __builtin_expect(__all(tmax - n_reg <= THRL), 1)) alpha = 1.f;
    else { const float nn = FIRST ? ceilf(tmax) : fmaxf(n_reg, ceilf(tmax)); alpha = FIRST ? 1.f : __builtin_amdgcn_exp2f(n_reg - nn); n_reg = nn; sc_reg = __builtin_amdgcn_exp2f(nn - 5.0f); }
#pragma unroll
    for (int r = 0; r < 16; ++r) p0[r] = __builtin_amdgcn_exp2f(p0[r]);
}
__device__ __forceinline__ void finishSM8(f32x16& p0, f32x16& p1, float sc, v8i& pa) {
#pragma unroll
    for (int r = 0; r < 16; ++r) p1[r] = __builtin_amdgcn_exp2f(p1[r]);
    pa = (v8i){(int)cvt_pk4_bf8_sc(p0[0], p0[1], p0[2], p0[3], sc), (int)cvt_pk4_bf8_sc(p0[4], p0[5], p0[6], p0[7], sc),
               (int)cvt_pk4_bf8_sc(p0[8], p0[9], p0[10], p0[11], sc), (int)cvt_pk4_bf8_sc(p0[12], p0[13], p0[14], p0[15], sc),
               (int)cvt_pk4_bf8_sc(p1[0], p1[1], p1[2], p1[3], sc), (int)cvt_pk4_bf8_sc(p1[4], p1[5], p1[6], p1[7], sc),
               (int)cvt_pk4_bf8_sc(p1[8], p1[9], p1[10], p1[11], sc), (int)cvt_pk4_bf8_sc(p1[12], p1[13], p1[14], p1[15], sc)};
}
__device__ __forceinline__ void qkt8(f32x16& p0, f32x16& p1, const char* Ks, const v8i (&qf)[2], int r32, int hi) {
    p0 = f32x16{}; p1 = f32x16{};
#pragma unroll
    for (int ks = 0; ks < 2; ++ks) { const int g0 = ks * 4 + hi * 2;
        const v8i a0 = cat8(*(const u32x4*)(Ks + r32 * 128 + (((g0) ^ ((r32 >> 1) & 7)) << 4)), *(const u32x4*)(Ks + r32 * 128 + (((g0 + 1) ^ ((r32 >> 1) & 7)) << 4)));
        const v8i a1 = cat8(*(const u32x4*)(Ks + (32 + r32) * 128 + (((g0) ^ ((r32 >> 1) & 7)) << 4)), *(const u32x4*)(Ks + (32 + r32) * 128 + (((g0 + 1) ^ ((r32 >> 1) & 7)) << 4)));
        p0 = __builtin_amdgcn_mfma_scale_f32_32x32x64_f8f6f4(a0, qf[ks], p0, 0, 0, 0, 0x7D7D7D7D, 0, 0x7A7A7A7A);
        p1 = __builtin_amdgcn_mfma_scale_f32_32x32x64_f8f6f4(a1, qf[ks], p1, 0, 0, 0, 0x7D7D7D7D, 0, 0x7A7A7A7A); }
}
__device__ __forceinline__ void pv8(f32x16* o, f32x16& lacc, const char* Vs, const v8i pa, int r32, int hi) {
    v8i vf[4];
#pragma unroll
    for (int d0 = 0; d0 < 4; ++d0) vf[d0] = cat8(*(const u32x4*)(Vs + (32 * d0 + r32) * 80 + hi * 32), *(const u32x4*)(Vs + (32 * d0 + r32) * 80 + hi * 32 + 16));
    asm volatile("s_waitcnt lgkmcnt(0)" ::: "memory"); SBAR();
#pragma unroll
    for (int d0 = 0; d0 < 4; ++d0) o[d0] = __builtin_amdgcn_mfma_scale_f32_32x32x64_f8f6f4(pa, vf[d0], o[d0], 1, 0, 0, 0x7A7A7A7A, 0, 0x7D7D7D7D);
    { const v8i ones = {0x48484848, 0x48484848, 0x48484848, 0x48484848, 0x48484848, 0x48484848, 0x48484848, 0x48484848};
      lacc = __builtin_amdgcn_mfma_scale_f32_32x32x64_f8f6f4(pa, ones, lacc, 1, 0, 0, 0x7A7A7A7A, 0, 0x7D7D7D7D); }
}
template <int LDQ, int LDO>
__device__ __forceinline__ void attn_fp8_body(const bf16_t* __restrict__ Qb, const unsigned char* __restrict__ K8h, const unsigned char* __restrict__ VT8h, bf16_t* __restrict__ Ob, int seq, char* lds, int wv,
                                              const float* qg, const f32x2* T1, int tq0) {
    const int tid = fresh_tid(wv), wid = __builtin_amdgcn_readfirstlane(tid >> 6), lane = tid & 63, r32 = lane & 31, hi = lane >> 5;
    char* K_lds = lds; char* V_lds = lds + A8_VOFF;
    float* wsp = (float*)(lds + A8_WS) + wid * 64; float* li_l = wsp; float* al_l = wsp + 32;
    v8i qf[2];
    {
        bf16x8 qr[8];
        const bf16_t* Qw = Qb + (long)(wid * 32 + r32) * LDQ + hi * 8;
#pragma unroll
        for (int d0 = 0; d0 < 8; ++d0) qr[d0] = *(const bf16x8*)(Qw + d0 * 16);
        float ss = 0.f;
#pragma unroll
        for (int d0 = 0; d0 < 8; ++d0)
#pragma unroll
            for (int j = 0; j < 8; ++j) { const float x = bf2f(qr[d0][j]); ss += x * x; }
        { auto rr = __builtin_amdgcn_permlane32_swap(__float_as_uint(ss), __float_as_uint(ss), false, false); ss = __uint_as_float(rr[0]) + __uint_as_float(rr[1]); }
        const float rstd = (4.0f * 8.0f * ATT_SCALE * 1.4426950408889634f) / sqrtf(ss * (1.0f / 128.0f) + EPS);
        const int t = tq0 + wid * 32 + r32;
        unsigned qb8[8][2];
#pragma unroll
        for (int hf = 0; hf < 2; ++hf) { const int pos = hf ? (t & 63) : (t >> 6);
#pragma unroll
            for (int a = 0; a < 2; ++a) { const int d1 = 4 * hf + a, d2 = d1 + 2;
                const f32x4* tp = (const f32x4*)(T1 + pos * 32 + 16 * a + 8 * hi); const f32x4 c01 = tp[0], c23 = tp[1], c45 = tp[2], c67 = tp[3];
                const float cs_[8] = {c01[0], c01[2], c23[0], c23[2], c45[0], c45[2], c67[0], c67[2]}, sn_[8] = {c01[1], c01[3], c23[1], c23[3], c45[1], c45[3], c67[1], c67[3]};
                const f32x4 g1a = *(const f32x4*)(qg + 16 * d1 + 8 * hi), g1b = *(const f32x4*)(qg + 16 * d1 + 8 * hi + 4), g2a = *(const f32x4*)(qg + 16 * d2 + 8 * hi), g2b = *(const f32x4*)(qg + 16 * d2 + 8 * hi + 4);
                float o1[8], o2[8];
#pragma unroll
                for (int j = 0; j < 8; ++j) { const float y1 = bf2f(qr[d1][j]) * rstd * (j < 4 ? g1a[j & 3] : g1b[j & 3]), y2 = bf2f(qr[d2][j]) * rstd * (j < 4 ? g2a[j & 3] : g2b[j & 3]);
                    o1[j] = y1 * cs_[j] - y2 * sn_[j]; o2[j] = y2 * cs_[j] + y1 * sn_[j]; }
                qb8[d1][0] = cvt_pk4_fp8(o1[0], o1[1], o1[2], o1[3]); qb8[d1][1] = cvt_pk4_fp8(o1[4], o1[5], o1[6], o1[7]);
                qb8[d2][0] = cvt_pk4_fp8(o2[0], o2[1], o2[2], o2[3]); qb8[d2][1] = cvt_pk4_fp8(o2[4], o2[5], o2[6], o2[7]);
                asm volatile("" ::: "memory"); __builtin_amdgcn_sched_barrier(0); } }
#pragma unroll
        for (int ks = 0; ks < 2; ++ks) qf[ks] = (v8i){(int)qb8[4 * ks][0], (int)qb8[4 * ks][1], (int)qb8[4 * ks + 1][0], (int)qb8[4 * ks + 1][1], (int)qb8[4 * ks + 2][0], (int)qb8[4 * ks + 2][1], (int)qb8[4 * ks + 3][0], (int)qb8[4 * ks + 3][1]};
    }
    float n_reg = 0.f, sc_reg = 1.f; f32x16 o[4] = {}; f32x16 lacc = {};
    const int kkey = tid >> 3, kst = kkey * 128 + (((tid & 7) ^ ((kkey >> 1) & 7)) << 4), vst = (tid >> 2) * 80 + (tid & 3) * 16;
    const unsigned koff = (unsigned)tid * 16u;
    struct { u32x4 ks, vs; } sr_[2];
#define SLOAD(i, tl) do { sr_[i].ks = *(const u32x4*)((const char*)K8h + (size_t)(tl) * 8192 + koff); sr_[i].vs = *(const u32x4*)((const char*)VT8h + (size_t)(tl) * 8192 + koff); } while (0)
#define SWRITE(b, i) do { *(u32x4*)(K_lds + (b) * A8_K + kst) = sr_[i].ks; *(u32x4*)(V_lds + (b) * A8_V + vst) = sr_[i].vs; } while (0)
#define SWAIT() asm volatile("s_waitcnt vmcnt(2)" ::: "memory")
#define RESC(a) do { if (__any((a) < 1.f)) { if (hi == 0) al_l[r32] = (a); asm volatile("s_waitcnt lgkmcnt(0)" ::: "memory"); \
    _Pragma("unroll") for (int r = 0; r < 16; ++r) { const float _a = al_l[crow(r, hi)]; lacc[r] *= _a; _Pragma("unroll") for (int d = 0; d < 4; ++d) o[d][r] *= _a; } } } while (0)
    f32x16 pA0, pA1, pB0, pB1; float alA, alB; v8i pa; const int NT = seq / 64;
    constexpr int SE = 0, SO = 1;
    SLOAD(SE, 0); asm volatile("s_waitcnt vmcnt(0)" ::: "memory"); SWRITE(0, SE); __syncthreads();
    qkt8(pA0, pA1, K_lds, qf, r32, hi); partialSM8<true>(pA0, pA1, n_reg, sc_reg, alA);
    SLOAD(SO, 1); if (2 < NT) SLOAD(SE, 2);
    SWAIT(); SWRITE(1, SO); __syncthreads();
    for (int j = 1; j + 1 < NT; j += 2) {
        SBAR(); qkt8(pB0, pB1, K_lds + A8_K, qf, r32, hi);
        finishSM8(pA0, pA1, sc_reg, pa); SBAR();
        SLOAD(SO, j + 2); SBAR();
        pv8(o, lacc, V_lds, pa, r32, hi); partialSM8<false>(pB0, pB1, n_reg, sc_reg, alB);
        __syncthreads(); SWAIT(); SWRITE(0, SE);
        RESC(alB); __syncthreads();
        SBAR(); qkt8(pA0, pA1, K_lds, qf, r32, hi);
        finishSM8(pB0, pB1, sc_reg, pa); SBAR();
        if (j + 3 < NT) SLOAD(SE, j + 3); SBAR();
        pv8(o, lacc, V_lds + A8_V, pa, r32, hi); partialSM8<false>(pA0, pA1, n_reg, sc_reg, alA);
        __syncthreads(); SWAIT(); SWRITE(1, SO);
        RESC(alA); __syncthreads();
    }
    SBAR(); qkt8(pB0, pB1, K_lds + A8_K, qf, r32, hi);
    finishSM8(pA0, pA1, sc_reg, pa); SBAR();
    pv8(o, lacc, V_lds, pa, r32, hi); partialSM8<false>(pB0, pB1, n_reg, sc_reg, alB);
    __syncthreads(); RESC(alB);
    finishSM8(pB0, pB1, sc_reg, pa); SBAR();
    pv8(o, lacc, V_lds + A8_V, pa, r32, hi);
    const int hi_e = lane_id() >> 5;
    (void)li_l; (void)n_reg;
    float rli[16];
#pragma unroll
    for (int r = 0; r < 16; ++r) rli[r] = __builtin_amdgcn_rcpf(lacc[r]);
    const int lane_e = lane_id(), r32e = lane_e & 31;
#pragma unroll
    for (int r = 0; r < 16; ++r) { const unsigned oo = (unsigned)((wid * 32 + crow(r, hi_e)) * LDO + r32e) * 2u;
#pragma unroll
        for (int d0 = 0; d0 < 4; ++d0) *(bf16_t*)((char*)Ob + (oo + (unsigned)(d0 * 64))) = (bf16_t)(cvt_pk_bf16(o[d0][r] * rli[r], 0.f) & 0xffffu); }
    __syncthreads();
#undef SLOAD
#undef SWRITE
#undef SWAIT
#undef RESC
}
__device__ __forceinline__ void gqa_attn_phase(const bf16_t* QKV, bf16_t* AO, char* lds, int G, int c, int wv, const float* qg, const f32x2* T1, const unsigned char* K8, const unsigned char* VT8) {
    const int per = G / 8, x = c % 8, j = c / 8;
#pragma unroll 1
    for (int u = j; u < 2 * 128; u += per) {
        const int pair = x * 2 + u / 128, uip = u % 128, hg = uip / 32, qb = uip % 32;
        const int b = pair >> 1, kvh = pair & 1, h = kvh * 4 + hg;
        const size_t row0 = (size_t)b * SEQ;
        if (FP8_ATTN) attn_fp8_body<1536, 1024>(QKV + (row0 + qb * 256) * 1536 + h * 128, K8 + (size_t)pair * SEQ * 128, VT8 + (size_t)pair * SEQ * 128, AO + (row0 + qb * 256) * 1024 + h * 128, SEQ, lds, wv, qg, T1, qb * 256);
        else attn_dense_body<1536, 1536, 1024, true>(QKV + (row0 + qb * 256) * 1536 + h * 128, QKV + row0 * 1536 + 1024 + kvh * 128, QKV + row0 * 1536 + 1280 + kvh * 128,
                                                AO + (row0 + qb * 256) * 1024 + h * 128, SEQ, lds, wv, qg, T1, qb * 256);
    }
}

template <int KS> __device__ __forceinline__ void pv_band_step(f32x16* o, int vb, const bf16x8 pa) {
    const s16x4 l0 = tr_read<v_rd_off(0, KS, 0)>(vb), h0 = tr_read<v_rd_off(0, KS, 1)>(vb), l1 = tr_read<v_rd_off(1, KS, 0)>(vb), h1 = tr_read<v_rd_off(1, KS, 1)>(vb);
    const s16x4 l2 = tr_read<v_rd_off(2, KS, 0)>(vb), h2 = tr_read<v_rd_off(2, KS, 1)>(vb), l3 = tr_read<v_rd_off(3, KS, 0)>(vb), h3 = tr_read<v_rd_off(3, KS, 1)>(vb);
    asm volatile("s_waitcnt lgkmcnt(0)" ::: "memory"); SBAR();
    o[0] = __builtin_amdgcn_mfma_f32_32x32x16_bf16(pa, PKV(l0, h0), o[0], 0, 0, 0);
    o[1] = __builtin_amdgcn_mfma_f32_32x32x16_bf16(pa, PKV(l1, h1), o[1], 0, 0, 0);
    o[2] = __builtin_amdgcn_mfma_f32_32x32x16_bf16(pa, PKV(l2, h2), o[2], 0, 0, 0);
    o[3] = __builtin_amdgcn_mfma_f32_32x32x16_bf16(pa, PKV(l3, h3), o[3], 0, 0, 0);
}
constexpr int DIL_LI = 98304, DIL_TT = DIL_LI + 2048, DIL_LDS_END = DIL_TT + 384 * 128;
static_assert(DIL_LDS_END <= LDS_BYTES, "dilated attention LDS");
__device__ __forceinline__ void dil_attn_phase(const bf16_t* QKVD, bf16_t* OG, float* LSE, char* lds, int G, int c, int wv, const float* qg, const float* kg, const f32x2* T2) {
    const int tid0 = fresh_tid(wv), wid = __builtin_amdgcn_readfirstlane(tid0 >> 6);
    char* KV = lds;
    const char* TT = lds + DIL_TT;
    constexpr float C = ATT_SCALE * 1.4426950408889634f;
#if FP8_QKVD
    u32x2 kN[12], qN[8];
#define DIL_PREFETCH(UU, LANE) do { const int _u = (UU); const int _rp = _u & 31, _h = (_u >> 5) & 7, _g = (_u >> 8) % 3, _bl = _u / 768; \
        const int _dsh = 2 * _g, _dil = 1 << _dsh, _nbk = 32 >> _dsh, _r = _rp / _nbk, _pb = _rp % _nbk, _Mres = SEQ >> _dsh; \
        const char* _bb = (const char*)QKVD + ((size_t)_bl * SEQ * DIL_N + _g * 3072 + _h * 128); \
        const int _tid = (wid << 6) | (LANE), _c16 = _tid & 15, _rb = _tid >> 4, _r32 = (LANE) & 31, _hi = (LANE) >> 5; \
        _Pragma("unroll") for (int it = 0; it < 12; ++it) { int _p = 256 * _pb - 64 + _rb + 32 * it; _p = _p < 0 ? 0 : (_p >= _Mres ? _Mres - 1 : _p); \
            kN[it] = *(const u32x2*)(_bb + ((unsigned)(_r + _dil * _p) * (unsigned)DIL_N + (unsigned)(1024 + _c16 * 8))); } \
        const unsigned _qo = (unsigned)(_r + _dil * (256 * _pb + 32 * wid + _r32)) * (unsigned)DIL_N + (unsigned)(_hi * 8); \
        _Pragma("unroll") for (int d0 = 0; d0 < 8; ++d0) qN[d0] = *(const u32x2*)(_bb + (_qo + (unsigned)(d0 * 16))); } while (0)
    if (c < DIL_CB * 3 * 8 * 32) { int l0 = tid0 & 63; asm volatile("" : "+v"(l0)); DIL_PREFETCH(c, l0); }
#endif
#pragma unroll 1
    for (int u = c; u < DIL_CB * 3 * 8 * 32; u += G) {
        int lane_l = tid0 & 63; asm volatile("" : "+v"(lane_l));
        const int lane = lane_l, tid = (wid << 6) | lane, r32 = lane & 31, hi = lane >> 5, c16 = tid & 15, rbase = tid >> 4;
        float* li_l = (float*)(lds + DIL_LI) + wid * 64;
        const int rp = u & 31, h = (u >> 5) & 7, g = (u >> 8) % 3, bl = u / 768;
        const int dsh = 2 * g, dil = 1 << dsh, nbk = 32 >> dsh, r = rp / nbk, pb = rp % nbk, Mres = SEQ >> dsh;
        constexpr int QES = FP8_QKVD ? 1 : 2;
        const char* baseb = (const char*)QKVD + ((size_t)bl * SEQ * DIL_N + g * 3072 + h * 128) * QES;
#define DIL_LD8(DST, OFF) do { if (FP8_QKVD) { const u32x2 _w = *(const u32x2*)(baseb + (OFF)); \
            DST[0] = __builtin_amdgcn_cvt_f32_fp8((int)_w.x, 0); DST[1] = __builtin_amdgcn_cvt_f32_fp8((int)_w.x, 1); DST[2] = __builtin_amdgcn_cvt_f32_fp8((int)_w.x, 2); DST[3] = __builtin_amdgcn_cvt_f32_fp8((int)_w.x, 3); \
            DST[4] = __builtin_amdgcn_cvt_f32_fp8((int)_w.y, 0); DST[5] = __builtin_amdgcn_cvt_f32_fp8((int)_w.y, 1); DST[6] = __builtin_amdgcn_cvt_f32_fp8((int)_w.y, 2); DST[7] = __builtin_amdgcn_cvt_f32_fp8((int)_w.y, 3); } \
          else { const bf16x8 _v = *(const bf16x8*)(baseb + (OFF)); _Pragma("unroll") for (int _k = 0; _k < 8; ++_k) DST[_k] = bf2f(_v[_k]); } } while (0)
        const int p0 = 256 * pb + 32 * wid;
#pragma unroll
        for (int jj = 0; jj < 6; ++jj) { const int i = tid + 512 * jj, lr = i >> 3, part = i & 7; int p = 256 * pb - 64 + lr; p = p < 0 ? 0 : (p >= Mres ? Mres - 1 : p);
            __builtin_amdgcn_global_load_lds((const unsigned*)((const char*)T2 + (size_t)(r + dil * p) * 128 + part * 16), (LAS unsigned*)(lds + DIL_TT + (wid * 64 + 512 * jj) * 16), 16, 0, 0); }
        u32x4 kreg[12];
#if FP8_QKVD
#pragma unroll
        for (int it = 0; it < 12; ++it) kreg[it] = (u32x4){kN[it].x, kN[it].y, 0u, 0u};
#else
#pragma unroll
        for (int it = 0; it < 12; ++it) { const int lr = rbase + 32 * it, p = 256 * pb - 64 + lr; kreg[it] = (u32x4){0u, 0u, 0u, 0u};
            if (p >= 0 && p < Mres) { const unsigned ko = (unsigned)(r + dil * p) * (unsigned)(DIL_N * QES) + (unsigned)((1024 + c16 * 8) * QES);
                if (FP8_QKVD) { const u32x2 w = *(const u32x2*)(baseb + ko); kreg[it].x = w.x; kreg[it].y = w.y; } else kreg[it] = *(const u32x4*)(baseb + ko); } }
#endif
        u32x4 qraw[8];
#if FP8_QKVD
#pragma unroll
        for (int d0 = 0; d0 < 8; ++d0) qraw[d0] = (u32x4){qN[d0].x, qN[d0].y, 0u, 0u};
#else
        { const unsigned qo = (unsigned)(r + dil * (p0 + r32)) * (unsigned)(DIL_N * QES) + (unsigned)(hi * 8 * QES);
#pragma unroll
          for (int d0 = 0; d0 < 8; ++d0) { if (FP8_QKVD) { const u32x2 w = *(const u32x2*)(baseb + (qo + (unsigned)(d0 * 16))); qraw[d0] = (u32x4){w.x, w.y, 0u, 0u}; } else qraw[d0] = *(const u32x4*)(baseb + (qo + (unsigned)(d0 * 32))); } }
#endif
        bf16x8 qr[8];
#define DIL_UNPK(DST, RAW) do { if (FP8_QKVD) { \
            DST[0] = __builtin_amdgcn_cvt_f32_fp8((int)(RAW).x, 0); DST[1] = __builtin_amdgcn_cvt_f32_fp8((int)(RAW).x, 1); DST[2] = __builtin_amdgcn_cvt_f32_fp8((int)(RAW).x, 2); DST[3] = __builtin_amdgcn_cvt_f32_fp8((int)(RAW).x, 3); \
            DST[4] = __builtin_amdgcn_cvt_f32_fp8((int)(RAW).y, 0); DST[5] = __builtin_amdgcn_cvt_f32_fp8((int)(RAW).y, 1); DST[6] = __builtin_amdgcn_cvt_f32_fp8((int)(RAW).y, 2); DST[7] = __builtin_amdgcn_cvt_f32_fp8((int)(RAW).y, 3); } \
          else { const bf16x8 _v = __builtin_bit_cast(bf16x8, (RAW)); _Pragma("unroll") for (int _k = 0; _k < 8; ++_k) DST[_k] = bf2f(_v[_k]); } } while (0)
        const f32x4 gk0 = *(const f32x4*)(kg + 8 * c16), gk1 = *(const f32x4*)(kg + 8 * c16 + 4);
        asm volatile("s_waitcnt vmcnt(0)" ::: "memory");
        __syncthreads();
#pragma unroll
        for (int it = 0; it < 12; ++it) { const int lr = rbase + 32 * it;
            float y[8]; float ss = 0.f; DIL_UNPK(y, kreg[it]);
#pragma unroll
            for (int k = 0; k < 8; ++k) ss += y[k] * y[k];
            ss = row16_sum(ss);
            const float rstd = 1.0f / sqrtf(ss * (1.0f / 128.0f) + EPS);
#pragma unroll
            for (int k = 0; k < 8; ++k) y[k] *= rstd * (k < 4 ? gk0[k & 3] : gk1[k & 3]);
            const f32x4* tp = (const f32x4*)(TT + lr * 128 + (c16 & 1) * 64); const f32x4 t0 = tp[0], t1 = tp[1], t2 = tp[2], t3 = tp[3];
            const float cs_[8] = {t0[0], t0[2], t1[0], t1[2], t2[0], t2[2], t3[0], t3[2]}, sn_[8] = {t0[1], t0[3], t1[1], t1[3], t2[1], t2[3], t3[1], t3[3]};
            float o[8];
#pragma unroll
            for (int k = 0; k < 8; ++k) { const float py = dpp_mov<0x4E>(y[k]); const float rot = (c16 & 2) ? (y[k] * cs_[k] + py * sn_[k]) : (y[k] * cs_[k] - py * sn_[k]); o[k] = (c16 < 4) ? rot : y[k]; }
            u32x4 w; w.x = cvt_pk_bf16(o[0], o[1]); w.y = cvt_pk_bf16(o[2], o[3]); w.z = cvt_pk_bf16(o[4], o[5]); w.w = cvt_pk_bf16(o[6], o[7]);
            *(u32x4*)(KV + KSWZ(lr, c16 * 16)) = w; }
        { float ss = 0.f; float qx[8][8];
#pragma unroll
          for (int d0 = 0; d0 < 8; ++d0) { DIL_UNPK(qx[d0], qraw[d0]);
#pragma unroll
              for (int j = 0; j < 8; ++j) ss += qx[d0][j] * qx[d0][j]; }
          { auto rr = __builtin_amdgcn_permlane32_swap(__float_as_uint(ss), __float_as_uint(ss), false, false); ss = __uint_as_float(rr[0]) + __uint_as_float(rr[1]); }
          const float rstd = 1.0f / sqrtf(ss * (1.0f / 128.0f) + EPS);
          const f32x4* tp = (const f32x4*)(TT + (64 + 32 * wid + r32) * 128 + hi * 64); const f32x4 t0 = tp[0], t1 = tp[1], t2 = tp[2], t3 = tp[3];
          const float cs_[8] = {t0[0], t0[2], t1[0], t1[2], t2[0], t2[2], t3[0], t3[2]}, sn_[8] = {t0[1], t0[3], t1[1], t1[3], t2[1], t2[3], t3[1], t3[3]};
#pragma unroll
          for (int d0 = 0; d0 < 8; d0 += 2) { const f32x4 ga = *(const f32x4*)(qg + 16 * d0 + 8 * hi), gb = *(const f32x4*)(qg + 16 * d0 + 8 * hi + 4), gc = *(const f32x4*)(qg + 16 * d0 + 16 + 8 * hi), gd = *(const f32x4*)(qg + 16 * d0 + 16 + 8 * hi + 4);
              float o1[8], o2[8];
#pragma unroll
              for (int j = 0; j < 8; ++j) { const float y1 = qx[d0][j] * rstd * (j < 4 ? ga[j & 3] : gb[j & 3]), y2 = qx[d0 + 1][j] * rstd * (j < 4 ? gc[j & 3] : gd[j & 3]);
                  if (d0 == 0) { o1[j] = y1 * cs_[j] - y2 * sn_[j]; o2[j] = y2 * cs_[j] + y1 * sn_[j]; } else { o1[j] = y1; o2[j] = y2; } }
              u32x4 w1, w2; w1.x = cvt_pk_bf16(o1[0], o1[1]); w1.y = cvt_pk_bf16(o1[2], o1[3]); w1.z = cvt_pk_bf16(o1[4], o1[5]); w1.w = cvt_pk_bf16(o1[6], o1[7]);
              w2.x = cvt_pk_bf16(o2[0], o2[1]); w2.y = cvt_pk_bf16(o2[2], o2[3]); w2.z = cvt_pk_bf16(o2[4], o2[5]); w2.w = cvt_pk_bf16(o2[6], o2[7]);
              qr[d0] = __builtin_bit_cast(bf16x8, w1); qr[d0 + 1] = __builtin_bit_cast(bf16x8, w2); } }
        u32x4 vreg[12];
#pragma unroll
        for (int it = 0; it < 12; ++it) { const int lr = rbase + 32 * it, p = 256 * pb - 64 + lr; vreg[it] = (u32x4){0u, 0u, 0u, 0u};
            if (p >= 0 && p < Mres) { const unsigned vo = (unsigned)(r + dil * p) * (unsigned)(DIL_N * QES) + (unsigned)((2048 + c16 * 8) * QES);
                if (FP8_QKVD) { const u32x2 w = *(const u32x2*)(baseb + vo); vreg[it].x = w.x; vreg[it].y = w.y; } else vreg[it] = *(const u32x4*)(baseb + vo); } }
        __syncthreads();
#if FP8_QKVD
        if (u + G < DIL_CB * 3 * 8 * 32) DIL_PREFETCH(u + G, lane);
#endif
        f32x16 s[5];
#pragma unroll
        for (int kt = 0; kt < 5; ++kt) { s[kt] = f32x16{};
#pragma unroll
            for (int d0 = 0; d0 < 8; ++d0) { const int lr = 32 * wid + 32 * kt + r32; const bf16x8 a = *(const bf16x8*)(KV + KSWZ(lr, (d0 * 16 + hi * 8) * 2));
                s[kt] = __builtin_amdgcn_mfma_f32_32x32x16_bf16(a, qr[d0], s[kt], 0, 0, 0); } }
        float mx = -3.0e38f;
        const bool edge = (p0 - 64 < 0) || (p0 + 128 + 35 - 64 >= Mres);
        if (edge) {
#pragma unroll
            for (int kt = 0; kt < 5; ++kt)
#pragma unroll
                for (int rr = 0; rr < 16; ++rr) { const int kp = p0 + 32 * kt + crow(rr, hi) - 64; if (!((kp >= 0) && (kp < Mres))) s[kt][rr] = -3.0e38f; } }
#pragma unroll
        for (int rr = 0; rr < 16; ++rr) { if (crow(rr, hi) < r32) s[0][rr] = -3.0e38f; if (crow(rr, hi) > r32) s[4][rr] = -3.0e38f; }
#pragma unroll
        for (int kt = 0; kt < 5; ++kt)
#pragma unroll
            for (int rr = 0; rr < 16; ++rr) mx = fmaxf(mx, s[kt][rr]);
        { auto rr = __builtin_amdgcn_permlane32_swap(__float_as_uint(mx), __float_as_uint(mx), false, false); mx = fmaxf(__uint_as_float(rr[0]), __uint_as_float(rr[1])); }
        float l = 0.f; const float mC = -mx * C;
#pragma unroll
        for (int kt = 0; kt < 5; ++kt)
#pragma unroll
            for (int rr = 0; rr < 16; ++rr) { const float pv = (s[kt][rr] > -1.0e38f) ? __builtin_amdgcn_exp2f(fmaf(s[kt][rr], C, mC)) : 0.f; s[kt][rr] = pv; l += pv; }
        { auto rr = __builtin_amdgcn_permlane32_swap(__float_as_uint(l), __float_as_uint(l), false, false); l = __uint_as_float(rr[0]) + __uint_as_float(rr[1]); }
        bf16x8 pa[10];
#pragma unroll
        for (int kt = 0; kt < 5; ++kt) { PK4(s[kt], 0, pa[2 * kt]); PK4(s[kt], 8, pa[2 * kt + 1]); }
        __syncthreads();
#pragma unroll
        for (int it = 0; it < 12; ++it) { const int lr = rbase + 32 * it;
            if (FP8_QKVD) { float vv[8]; DIL_UNPK(vv, vreg[it]); u32x4 w; w.x = cvt_pk_bf16(vv[0] * 0.25f, vv[1] * 0.25f); w.y = cvt_pk_bf16(vv[2] * 0.25f, vv[3] * 0.25f); w.z = cvt_pk_bf16(vv[4] * 0.25f, vv[5] * 0.25f); w.w = cvt_pk_bf16(vv[6] * 0.25f, vv[7] * 0.25f);
                *(u32x4*)(KV + v_st(lr, c16 * 8)) = w; }
            else *(u32x4*)(KV + v_st(lr, c16 * 8)) = vreg[it]; }
        __syncthreads();
        f32x16 o[4] = {};
        const int vb = (int)(uintptr_t)KV + v_rd_base(lane) + 2 * wid * 4096;
        pv_band_step<0>(o, vb, pa[0]); pv_band_step<1>(o, vb, pa[1]); pv_band_step<2>(o, vb, pa[2]); pv_band_step<3>(o, vb, pa[3]); pv_band_step<4>(o, vb, pa[4]);
        pv_band_step<5>(o, vb, pa[5]); pv_band_step<6>(o, vb, pa[6]); pv_band_step<7>(o, vb, pa[7]); pv_band_step<8>(o, vb, pa[8]); pv_band_step<9>(o, vb, pa[9]);
        if (hi == 0) li_l[r32] = l; asm volatile("s_waitcnt lgkmcnt(0)" ::: "memory");
        bf16_t* og = OG + ((size_t)g * DIL_ROWS + (size_t)bl * SEQ) * DM + h * 128;
        { float rl[16];
#pragma unroll
          for (int rr = 0; rr < 16; ++rr) rl[rr] = __builtin_amdgcn_rcpf(li_l[crow(rr, hi)]);
          char* ot = lds + DIL_TT + wid * (32 * 144);
#pragma unroll
          for (int half = 0; half < 2; ++half) {
#pragma unroll
              for (int rr = 0; rr < 16; ++rr)
#pragma unroll
                  for (int dd = 0; dd < 2; ++dd) *(bf16_t*)(ot + crow(rr, hi) * 144 + (dd * 32 + r32) * 2) = (bf16_t)(cvt_pk_bf16(o[2 * half + dd][rr] * rl[rr], 0.f) & 0xffffu);
              asm volatile("s_waitcnt lgkmcnt(0)" ::: "memory");
#pragma unroll
              for (int j = 0; j < 4; ++j) { const int lrow = (lane >> 3) + 8 * j; const u32x4 w = *(const u32x4*)(ot + lrow * 144 + (lane & 7) * 16);
                  *(u32x4*)(og + (size_t)(r + dil * (p0 + lrow)) * DM + half * 64 + (lane & 7) * 8) = w; }
              asm volatile("s_waitcnt lgkmcnt(0)" ::: "memory"); } }
        if (hi == 0) LSE[((size_t)g * DIL_ROWS + (size_t)bl * SEQ + r + dil * (p0 + r32)) * 8 + h] = mx * ATT_SCALE + __logf(l);
        __syncthreads();
    }
}
#undef DIL_LD8
#undef DIL_UNPK
#undef DIL_PREFETCH
__device__ __forceinline__ void dil_merge_phase(const bf16_t* OG, const float* LSE, bf16_t* AO, unsigned char* AO8, int G, int c, int wv) {
    const int tid = fresh_tid(wv), lane = tid & 63, wave = __builtin_amdgcn_readfirstlane(tid >> 6), h = lane >> 3;
    for (int rowb = c * 8 + wave; rowb < DIL_ROWS; rowb += G * 8 * 4) {
        float ls[4][3]; bf16x8 og[4][3][2];
#pragma unroll
        for (int r = 0; r < 4; ++r) { const int row = rowb + r * G * 8;
            if (row < DIL_ROWS) {
#pragma unroll
                for (int g = 0; g < 3; ++g) { ls[r][g] = LSE[((size_t)g * DIL_ROWS + row) * 8 + h]; const bf16x8* p = (const bf16x8*)(OG + ((size_t)g * DIL_ROWS + row) * DM + lane * 16); og[r][g][0] = p[0]; og[r][g][1] = p[1]; } } }
        asm volatile("" ::: "memory");
#pragma unroll
        for (int r = 0; r < 4; ++r) { const int row = rowb + r * G * 8;
            if (row < DIL_ROWS) {
                const float mx = fmaxf(ls[r][0], fmaxf(ls[r][1], ls[r][2]));
                float w[3]; float sum = 0.f;
#pragma unroll
                for (int g = 0; g < 3; ++g) { w[g] = __expf(ls[r][g] - mx); sum += w[g]; }
                const float inv = 1.0f / sum;
                float acc[16];
#pragma unroll
                for (int k = 0; k < 16; ++k) acc[k] = 0.f;
#pragma unroll
                for (int g = 0; g < 3; ++g) { const bf16x8 a = og[r][g][0], b = og[r][g][1]; const float wg = w[g] * inv;
#pragma unroll
                    for (int k = 0; k < 8; ++k) { acc[k] += wg * bf2f(a[k]); acc[8 + k] += wg * bf2f(b[k]); } }
                u32x4 o0, o1; o0.x = cvt_pk_bf16(acc[0], acc[1]); o0.y = cvt_pk_bf16(acc[2], acc[3]); o0.z = cvt_pk_bf16(acc[4], acc[5]); o0.w = cvt_pk_bf16(acc[6], acc[7]);
                o1.x = cvt_pk_bf16(acc[8], acc[9]); o1.y = cvt_pk_bf16(acc[10], acc[11]); o1.z = cvt_pk_bf16(acc[12], acc[13]); o1.w = cvt_pk_bf16(acc[14], acc[15]);
                if (AO8) { constexpr float sc = (float)(1 << F8S_AO); u32x4 q; q.x = cvt_pk4_fp8(acc[0] * sc, acc[1] * sc, acc[2] * sc, acc[3] * sc); q.y = cvt_pk4_fp8(acc[4] * sc, acc[5] * sc, acc[6] * sc, acc[7] * sc);
                    q.z = cvt_pk4_fp8(acc[8] * sc, acc[9] * sc, acc[10] * sc, acc[11] * sc); q.w = cvt_pk4_fp8(acc[12] * sc, acc[13] * sc, acc[14] * sc, acc[15] * sc); *(u32x4*)(AO8 + (size_t)row * DM + lane * 16) = q; }
                else { u32x4* op = (u32x4*)(AO + (size_t)row * DM + lane * 16); op[0] = o0; op[1] = o1; } } }
    }
}

constexpr int GU_SW = e8m0x4(F8S_WGU), GU_SA = e8m0x4(F8S_HN), DN_SW = e8m0x4(F8S_WD), DN_SA = e8m0x4(F8S_HID), RES_SA = e8m0x4(F8S_AO);
constexpr unsigned ALL_KINDS = (1u << 23) - 1u;
enum { K_PRO = 0, K_WIN, K_RG0, K_RGC, K_RG1, K_QKV1, K_QKNA, K_GQA, K_QKV2, K_QKND, K_DIL, K_MRG, K_RES, K_CAST, K_GU, K_DN, K_NORMR, K_SCAT, K_MGU, K_MDN, K_MDR, K_NORMY, K_FIN, K_COUNT };
template <unsigned MASK>
__global__ void __launch_bounds__(512, 2) mega(Params p) {
    extern __shared__ __attribute__((aligned(16))) unsigned char lds_raw[];
    LAS unsigned char* lds = (LAS unsigned char*)lds_raw;
    const int wv = __builtin_amdgcn_readfirstlane((int)threadIdx.x >> 6);
    const int G0 = gridDim.x, c0 = blockIdx.x, lo = p.lo, hi = p.hi < PHASE_LIMIT ? p.hi : PHASE_LIMIT;
    XcdBarrier bar; bar.bar = (unsigned*)(p.ws + WS_CTL); bar.x = 0; bar.st = nullptr;
    if (MASK == ALL_KINDS && hi - lo > 1) {
        const bool t0 = fresh_tid(wv) == 0;
        if (t0) *(LAS u32x4*)(lds + LDS_BAR) = (u32x4){0u, 0u, 0u, 0u};
        __syncthreads();
        bar = xcd_barrier_post((unsigned*)(p.ws + WS_CTL), (volatile LAS unsigned*)(lds + LDS_BAR), t0);
    }
    int ph = 0;
#define PH_BEGIN(KIND) if (((MASK >> (KIND)) & 1u) && ph >= lo && ph < hi) { for (int _rep = 0; _rep <= (int)(((unsigned)(DUP_MASK) >> (KIND)) & 1u); ++_rep) { if (_rep) __syncthreads(); unsigned char* ws = fresh_ptr(p.ws); float* out = fresh_ptr(p.out); int G = G0, c = c0; asm volatile("" : "+s"(G), "+s"(c));   \
        bf16_t* WB = (bf16_t*)(ws + WS_WB); bf16_t* XB = (bf16_t*)(ws + WS_XB); unsigned char* BIG = ws + WS_BIG; pg8::ss_t* SS = (pg8::ss_t*)(ws + WS_SS); bf16_t* AOB = (bf16_t*)out; unsigned char* X8 = (unsigned char*)out + OUT_X8; \
        (void)out; (void)WB; (void)XB; (void)BIG; (void)SS; (void)AOB; (void)X8;
#define PH_END   } if (MASK == ALL_KINDS && ph + 1 < hi) { bar.bar = (unsigned*)(fresh_ptr(p.ws) + WS_CTL); xcd_barrier(bar, fresh_tid(wv) == 0); } } ++ph;

    PH_BEGIN(K_PRO) prologue_phase(p, lds, G, c, wv); PH_END

#pragma unroll 1
    for (int L = 0; L < 4; ++L) {
        if (L == 0 || L == 3) {
            const int ib = L ? 32 : 1;
#define RG_PTRS const bf16_t* Gw = WB + (L ? O_L3_GATE : O_L0_GATE); bf16_t* GY = (bf16_t*)BIG; bf16_t* XBR = (bf16_t*)(BIG + (size_t)MT * DM * 2); \
            float* SUMP = (float*)(ws + WS_SUMP); float* SUMH = (float*)(ws + WS_SUMH); float* CARRY = (float*)(ws + WS_CARRY); (void)Gw; (void)GY; (void)XBR; (void)SUMP; (void)SUMH; (void)CARRY;
            PH_BEGIN(K_WIN) { RG_PTRS const bf16_t* Win = WB + (L ? O_L3_WIN : O_L0_WIN);
                const bool f8w = (L == 0) ? (((FP8_WIN) & 1) != 0) : (((FP8_WIN) & 8) != 0);
                pg8::Sched S{f8w ? (const char*)X8 : (const char*)XB, (const char*)Win, 0, nullptr, nullptr, MT / 256, 8, G, c, 0, 0, (const char*)SS}; pg8::EpiWin E{GY, XBR};
                if (f8w) pg8::gemm_phase<pg8::EpiWin, false, GU_SW, GU_SA>(lds, 1024, S, E, wv); else pg8::gemm_phase<pg8::EpiWin, false>(lds, 1024, S, E, wv); } PH_END
            PH_BEGIN(K_RG0) { RG_PTRS rg_phase<0>(XBR, GY, AOB, nullptr, Gw, p.in[ib + 2], p.in[ib + 3], p.in[ib + 5], p.in[ib + 7], p.in[ib + 8], SUMP, SUMH, CARRY, lds, G, c, wv); } PH_END
            PH_BEGIN(K_RGC) { RG_PTRS rg_carry_phase(SUMP, SUMH, CARRY, lds, G, c, wv); } PH_END
            PH_BEGIN(K_RG1) { RG_PTRS rg_phase<1>(XBR, GY, AOB, ((((FP8_RES) & 1) && L == 0) || (((FP8_RES) & 8) && L == 3)) ? (unsigned char*)out + OUT_AO8 : nullptr, Gw, p.in[ib + 2], p.in[ib + 3], p.in[ib + 5], p.in[ib + 7], p.in[ib + 8], SUMP, SUMH, CARRY, lds, G, c, wv); } PH_END
#undef RG_PTRS
        } else if (L == 1) {
            PH_BEGIN(K_QKV1) { bf16_t* QKV = (bf16_t*)BIG; pg8::Sched S{FP8_QKV1 ? (const char*)X8 : (const char*)XB, (const char*)(WB + O_L1_QKV), 0, nullptr, nullptr, MT / 256, 6, G, c, 0, 0, (const char*)SS}; pg8::EpiBf16 E{QKV, 1536};
                if (FP8_QKV1) pg8::gemm_phase<pg8::EpiBf16, false, GU_SW, GU_SA>(lds, 1024, S, E, wv); else pg8::gemm_phase<pg8::EpiBf16, false>(lds, 1024, S, E, wv); } PH_END
            PH_BEGIN(K_QKNA) { bf16_t* QKV = (bf16_t*)BIG; unsigned char* K8 = BIG + 192 * MiB; unsigned char* VT8 = BIG + 208 * MiB;
                if (FP8_ATTN) k8_prepass_phase(QKV, K8, p.in[17], (const f32x2*)(ws + WS_T1), G, c, wv); else qknorm_rope_phase<true>(QKV, MT, 1536, 8, 10, p.in[16], p.in[17], G, c, wv, nullptr);
                if (FP8_ATTN) { __syncthreads(); vt8_phase(QKV, VT8, (char*)lds_raw, G, c, wv); } } PH_END
            PH_BEGIN(K_GQA) { bf16_t* QKV = (bf16_t*)BIG; gqa_attn_phase(QKV, AOB, (char*)lds_raw, G, c, wv, p.in[16], (const f32x2*)(ws + WS_T1), BIG + 192 * MiB, BIG + 208 * MiB); } PH_END
        } else {
#define DIL_PTRS(BC) bf16_t* QKVD = (bf16_t*)BIG; bf16_t* OG = (bf16_t*)(BIG + BIG_OG); float* LSE = (float*)(ws + WS_LSE); const size_t r0 = (size_t)(BC) * DIL_ROWS; (void)QKVD; (void)OG; (void)LSE; (void)r0;
#define DIL_QKV(BC) { DIL_PTRS(BC) pg8::Sched S{FP8_QKV2 ? (const char*)X8 + r0 * DM : (const char*)(XB + r0 * DM), (const char*)(WB + O_L2_QKV), 0, nullptr, nullptr, DIL_ROWS / 256, DIL_N / 256, G, c, 0, 0, (const char*)(SS + r0 * 16)}; pg8::EpiBf16 E{QKVD, FP8_QKVD ? -DIL_N : DIL_N}; \
                if (FP8_QKV2) pg8::gemm_phase<pg8::EpiBf16, false, GU_SW, GU_SA>(lds, 1024, S, E, wv); else pg8::gemm_phase<pg8::EpiBf16, false>(lds, 1024, S, E, wv); }
            PH_BEGIN(K_QKV2) DIL_QKV(0) PH_END
#pragma unroll 1
            for (int bc = 0; bc < NBATCH / DIL_CB; ++bc) {
                PH_BEGIN(K_DIL) { DIL_PTRS(bc) dil_attn_phase(QKVD, OG, LSE, (char*)lds_raw, G, c, wv, p.in[26], p.in[27], (const f32x2*)(ws + WS_T2)); } PH_END
                PH_BEGIN(K_MRG) { { DIL_PTRS(bc) dil_merge_phase(OG, LSE, AOB + r0 * DM, ((FP8_RES) & 4) ? (unsigned char*)out + OUT_AO8 + r0 * DM : nullptr, G, c, wv); }
                    if (bc + 1 < NBATCH / DIL_CB) { __syncthreads(); DIL_QKV(bc + 1) } } PH_END
            }
#undef DIL_PTRS
#undef DIL_QKV
        }
        PH_BEGIN(K_RES) { const bf16_t* Wo = WB + (L == 0 ? O_L0_WOUT : L == 1 ? O_L1_WOUT : L == 2 ? O_L2_WOUT : O_L3_WOUT);
            int Lr = L; asm volatile("" : "+s"(Lr)); const bool f8r = (((FP8_RES) >> Lr) & 1) != 0;
            pg8::Sched S{f8r ? (const char*)out + OUT_AO8 : (const char*)AOB, (const char*)Wo, 0, nullptr, nullptr, MT / 256, 4, G, c, 0, 0, nullptr}; const bool x8o = (L == 0) ? F8GU(0) : (L == 2) ? F8GU(2) : false;
            pg8::EpiResid E{XB, SS + (size_t)MT * 16, 0, x8o ? X8 : nullptr};
            if (f8r) pg8::gemm_phase<pg8::EpiResid, false, GU_SW, RES_SA>(lds, 1024, S, E, wv); else pg8::gemm_phase<pg8::EpiResid, false>(lds, 1024, S, E, wv); } PH_END
        const int fnorm = (L == 0) ? 11 : (L == 1) ? 19 : (L == 2) ? 29 : 42;
        if ((L & 1) == 0) {
#define FM_DECL int Lf = L; asm volatile("" : "+s"(Lf)); const int fm = (Lf == 0) ? (F8GU(0) * 2 + F8DN(0)) : (F8GU(2) * 2 + F8DN(2)); const bool f8g = (fm & 2) != 0, f8d = (fm & 1) != 0; (void)f8g; (void)f8d;
#define DENSE_GU(CK) { FM_DECL const bf16_t* Wgu = WB + (L ? O_L2_WGU : O_L0_WGU); void* HID = (void*)(BIG + (size_t)(CK) * (224 * MiB)); const size_t r0 = (size_t)(CK) * (MT / 2); const pg8::ss_t* ssf = SS + (size_t)MT * 16; \
                    pg8::Sched S{f8g ? (const char*)X8 + r0 * DM : (const char*)(XB + r0 * DM), (const char*)Wgu, 0, nullptr, nullptr, MT / 512, 28, G, c, 0, 0, (const char*)(ssf + r0 * 16)}; \
                    if (fm == 3) { pg8::EpiSwiglu<true, 1> E{HID}; pg8::gemm_phase<pg8::EpiSwiglu<true, 1>, false, GU_SW, GU_SA>(lds, 1024, S, E, wv); } \
                    else if (fm == 2) { pg8::EpiSwiglu<false, 1> E{HID}; pg8::gemm_phase<pg8::EpiSwiglu<false, 1>, false, GU_SW, GU_SA>(lds, 1024, S, E, wv); } \
                    else if (fm == 1) { pg8::EpiSwiglu<true, 1> E{HID}; pg8::gemm_phase<pg8::EpiSwiglu<true, 1>, false>(lds, 1024, S, E, wv); } \
                    else { pg8::EpiSwiglu<false, 1> E{HID}; pg8::gemm_phase<pg8::EpiSwiglu<false, 1>, false>(lds, 1024, S, E, wv); } }
#define DENSE_DN(CK) { FM_DECL const bf16_t* Wd = WB + (L ? O_L2_WD : O_L0_WD); const char* HID = (const char*)(BIG + (size_t)(CK) * (224 * MiB)); const size_t r0 = (size_t)(CK) * (MT / 2); \
                    pg8::Sched S{HID, (const char*)Wd, 0, nullptr, nullptr, MT / 512, 4, G, c, 0, 1, nullptr}; const bool x8n = (L == 0) ? (FP8_QKV1 != 0) : (((FP8_WIN) & 8) != 0); \
                    pg8::EpiResid E{XB, SS, (int)r0, x8n ? X8 : nullptr}; \
                    if (f8d) pg8::gemm_phase<pg8::EpiResid, false, DN_SW, DN_SA>(lds, DFF, S, E, wv); else pg8::gemm_phase<pg8::EpiResid, false>(lds, DFF, S, E, wv); }
            PH_BEGIN(K_GU) DENSE_GU(0) PH_END
            PH_BEGIN(K_DN) DENSE_DN(0) __syncthreads(); DENSE_GU(1) PH_END
            PH_BEGIN(K_DN) DENSE_DN(1) PH_END
#undef DENSE_GU
#undef DENSE_DN
#undef FM_DECL
        } else {
#define FM_DECL int Lf = L; asm volatile("" : "+s"(Lf)); const int fm = (Lf == 1) ? (F8GU(1) * 2 + F8DN(1)) : (F8GU(3) * 2 + F8DN(3)); const bool f8g = (fm & 2) != 0, f8d = (fm & 1) != 0; (void)f8g; (void)f8d;
            PH_BEGIN(K_NORMR) { FM_DECL const pg8::ss_t* ssf = SS + (size_t)MT * 16;
                if (f8g) prep_phase<true, 0, true>(XB, nullptr, ssf, nullptr, p.in[fnorm], p.in[fnorm + 1], p.in[fnorm + 2], X8, nullptr, ws, lds, G, c, wv);
                else prep_phase<true, 0, false>(XB, nullptr, ssf, nullptr, p.in[fnorm], p.in[fnorm + 1], p.in[fnorm + 2], X8, nullptr, ws, lds, G, c, wv); } PH_END
            PH_BEGIN(K_SCAT) moe_scatter_phase(ws, SS + (size_t)MT * 16, lds, G, c, wv); PH_END
#define MOE_PTRS FM_DECL const int* META = (const int*)(ws + WS_META); const int* SIDX = (const int*)(ws + WS_SIDX); const float* SGATE = (const float*)(ws + WS_SGATE); bf16_t* HID = (bf16_t*)BIG; \
                bf16_t* YB = (bf16_t*)(BIG + BIG_Y); const int ntt = META[33]; int nR = ntt - 512; nR = nR < 0 ? 0 : (nR > 8 ? 8 : nR); const pg8::ss_t* ssf = SS + (size_t)MT * 16; \
                const bf16_t* Wgu = WB + (L == 1 ? O_L1_WGU : O_L3_WGU); const bf16_t* Wd = WB + (L == 1 ? O_L1_WD : O_L3_WD); const char* XA = f8g ? (const char*)X8 : (const char*)XB; \
                (void)SIDX; (void)SGATE; (void)HID; (void)YB; (void)nR; (void)Wgu; (void)Wd; (void)ssf; (void)XA;
#define MOE_GU(S, HP, SR0) { if (fm == 3) { pg8::EpiSwiglu<true, 2> E{HP}; pg8::gemm_phase<pg8::EpiSwiglu<true, 2>, true, GU_SW, GU_SA>(lds, 1024, S, E, wv); } \
                         else if (fm == 2) { pg8::EpiSwiglu<false, 2> E{HP}; pg8::gemm_phase<pg8::EpiSwiglu<false, 2>, true, GU_SW, GU_SA>(lds, 1024, S, E, wv); } \
                         else if (fm == 1) { pg8::EpiSwiglu<true, 2> E{HP}; pg8::gemm_phase<pg8::EpiSwiglu<true, 2>, true>(lds, 1024, S, E, wv); } \
                         else { pg8::EpiSwiglu<false, 2> E{HP}; pg8::gemm_phase<pg8::EpiSwiglu<false, 2>, true>(lds, 1024, S, E, wv); } }
            static_assert(F8DN(1) && F8DN(3), "the MoE pipeline double-buffers an fp8 HID (2 x 112 MiB below BIG_HIDR)");
#define MOE_HID(CK) ((bf16_t*)(BIG + (size_t)((CK) & 1) * (112 * MiB)))
            PH_BEGIN(K_MGU) { MOE_PTRS pg8::Sched S{XA, (const char*)Wgu, E_WGU * 2, META, SIDX, 128, 28, G, c, 0, 0, (const char*)(ws + WS_SRS)};
#if PROBE_EPI == 1
                if (_rep) { pg8::EpiNull<2> E{}; pg8::gemm_phase<pg8::EpiNull<2>, true, GU_SW, GU_SA>(lds, 1024, S, E, wv); } else
#elif PROBE_EPI == 4
                if (_rep) { pg8::Sched S2 = S; S2.hot = 1; pg8::EpiNull<2> E{}; pg8::gemm_phase<pg8::EpiNull<2>, true, GU_SW, GU_SA>(lds, 1024, S2, E, wv); } else
#elif PROBE_EPI == 2
                if (_rep) { pg8::EpiSwiglu<true, 2> E{MOE_HID(1)}; pg8::gemm_phase<pg8::EpiSwiglu<true, 2>, true, GU_SW, GU_SA>(lds, 256, S, E, wv); } else
#endif
                MOE_GU(S, MOE_HID(0), 0) } PH_END
#pragma unroll 1
            for (int ck = 0; ck < 4; ++ck) {
                PH_BEGIN(K_MDN) { MOE_PTRS
#if PROBE_EPI == 5 || PROBE_EPI == 6
                    if (_rep) { pg8::Sched S{(const char*)MOE_HID(ck), (const char*)Wd, E_WD * 2, META, nullptr, 128, 4, G, c, 128 * ck, 1, nullptr}; S.hot = (PROBE_EPI == 5); pg8::EpiNull<0> E{}; pg8::gemm_phase<pg8::EpiNull<0>, false, DN_SW, DN_SA>(lds, DFF, S, E, wv); } else
#endif
                    { pg8::Sched S{(const char*)MOE_HID(ck), (const char*)Wd, E_WD * 2, META, nullptr, 128, 4, G, c, 128 * ck, 1, (const char*)SIDX, (const char*)SGATE}; pg8::EpiMoeY E{YB}; if (f8d) pg8::gemm_phase<pg8::EpiMoeY, false, DN_SW, DN_SA>(lds, DFF, S, E, wv); else pg8::gemm_phase<pg8::EpiMoeY, false>(lds, DFF, S, E, wv); }
                    __syncthreads();
                    if ((PROBE_EPI == 3 || PROBE_EPI == 5 || PROBE_EPI == 6) && _rep) {} else
                    if (ck < 3) { pg8::Sched S{XA, (const char*)Wgu, E_WGU * 2, META, SIDX, 128, 28, G, c, 128 * (ck + 1), 0, (const char*)(ws + WS_SRS)}; MOE_GU(S, MOE_HID(ck + 1), 0) }
                    else if (nR > 0) { pg8::Sched S{XA, (const char*)Wgu, E_WGU * 2, META, SIDX, nR, 28, G, c, 512, 0, (const char*)(ws + WS_SRS)}; MOE_GU(S, (bf16_t*)(BIG + BIG_HIDR), 0) } } PH_END
            }
#undef MOE_HID
            PH_BEGIN(K_MDR) { MOE_PTRS
                if (nR > 0) { pg8::Sched S{(const char*)(BIG + BIG_HIDR), (const char*)Wd, E_WD * 2, META, nullptr, nR, 4, G, c, 512, 1, (const char*)SIDX, (const char*)SGATE}; pg8::EpiMoeY E{YB}; if (f8d) pg8::gemm_phase<pg8::EpiMoeY, false, DN_SW, DN_SA>(lds, DFF, S, E, wv); else pg8::gemm_phase<pg8::EpiMoeY, false>(lds, DFF, S, E, wv); }
                if (LATE_CVT && L == 1 && c >= 32) late_convert_l3gu(p, lds, G - 32, c - 32, wv); } PH_END
#undef MOE_PTRS
#undef MOE_GU
#undef FM_DECL
            if (L == 1) { PH_BEGIN(K_NORMY) prep_phase<false, 1, FP8_QKV2 != 0>(XB, (const bf16_t*)(BIG + BIG_Y), nullptr, SS, nullptr, nullptr, nullptr, X8, nullptr, ws, lds, G, c, wv); PH_END }
            if (L == 3) { PH_BEGIN(K_FIN) prep_phase<false, 2, false>(XB, (const bf16_t*)(BIG + BIG_Y), nullptr, nullptr, nullptr, nullptr, nullptr, nullptr, out, ws, lds, G, c, wv); PH_END }
        }
    }
#undef PH_BEGIN
#undef PH_END
}

constexpr int N_PHASES = 1 + (4 + 1 + 3) + (3 + 1 + 2 + 6 + 1) + (9 + 1 + 3) + (4 + 1 + 2 + 6 + 1);
struct KindTab { int k[N_PHASES + 8]; int n; };
constexpr KindTab build_kinds() {
    KindTab t{}; int n = 0; t.k[n++] = K_PRO;
    for (int L = 0; L < 4; ++L) {
        if (L == 0 || L == 3) { t.k[n++] = K_WIN; t.k[n++] = K_RG0; t.k[n++] = K_RGC; t.k[n++] = K_RG1; }
        else if (L == 1) { t.k[n++] = K_QKV1; t.k[n++] = K_QKNA; t.k[n++] = K_GQA; }
        else { t.k[n++] = K_QKV2; for (int bc = 0; bc < NBATCH / DIL_CB; ++bc) { t.k[n++] = K_DIL; t.k[n++] = K_MRG; } }
        t.k[n++] = K_RES;
        if ((L & 1) == 0) { t.k[n++] = K_GU; t.k[n++] = K_DN; t.k[n++] = K_DN; }
        else { t.k[n++] = K_NORMR; t.k[n++] = K_SCAT; t.k[n++] = K_MGU; for (int ck = 0; ck < 4; ++ck) t.k[n++] = K_MDN; t.k[n++] = K_MDR; t.k[n++] = (L == 1) ? K_NORMY : K_FIN; }
    }
    t.n = n; return t;
}
constexpr KindTab KINDS = build_kinds();
static_assert(KINDS.n == N_PHASES, "phase count");
typedef void (*mega_fn)(Params);
template <int K> struct FnTab { static void fill(mega_fn* f) { f[K] = mega<(1u << K)>; FnTab<K - 1>::fill(f); } };
template <> struct FnTab<-1> { static void fill(mega_fn*) {} };

extern "C" void kernel_launch(void* const* d_in, const int* in_sizes, int n_in, void* d_out, int out_size, void* d_ws, size_t ws_size, hipStream_t stream) {
    static int ok = 0; static mega_fn fns[K_COUNT + 1];
    if (ok == 0) {
        if (n_in != 47 || out_size != MT * DM || ws_size < WS_END) { fprintf(stderr, "kernel_launch: unexpected shapes: n_in %d out %d ws %zu (need %zu)\n", n_in, out_size, ws_size, (size_t)WS_END); ok = -1; return; }
#if SPLIT_LAUNCHES
        FnTab<K_COUNT - 1>::fill(fns);
        for (int k = 0; k < K_COUNT; ++k)
            if (hipFuncSetAttribute((const void*)fns[k], hipFuncAttributeMaxDynamicSharedMemorySize, LDS_BYTES) != hipSuccess) { fprintf(stderr, "kernel_launch: hipFuncSetAttribute failed\n"); ok = -1; return; }
#else
        fns[K_COUNT] = mega<ALL_KINDS>;
        if (hipFuncSetAttribute((const void*)fns[K_COUNT], hipFuncAttributeMaxDynamicSharedMemorySize, LDS_BYTES) != hipSuccess) { fprintf(stderr, "kernel_launch: hipFuncSetAttribute failed\n"); ok = -1; return; }
#endif
        ok = 1;
    }
    if (ok < 0) return;
    (void)hipMemsetAsync((char*)d_ws + WS_CTL, 0, 65536, stream);
    Params p{};
    for (int i = 0; i < 47; ++i) p.in[i] = (const float*)d_in[i];
    p.out = (float*)d_out; p.ws = (unsigned char*)d_ws;
    const int nph = N_PHASES < PHASE_LIMIT ? N_PHASES : PHASE_LIMIT;
#if SPLIT_LAUNCHES
    for (int ph = 0; ph < nph; ++ph) { p.lo = ph; p.hi = ph + 1; hipLaunchKernelGGL(fns[KINDS.k[ph]], dim3(NWG), dim3(512), LDS_BYTES, stream, p); }
#else
    p.lo = 0; p.hi = nph; hipLaunchKernelGGL(fns[K_COUNT], dim3(NWG), dim3(512), LDS_BYTES, stream, p);
#endif
    const hipError_t le = hipPeekAtLastError();
    if (le != hipSuccess) fprintf(stderr, "kernel_launch: launch failed: %s\n", hipGetErrorName(le));
}
```

```cpp
#include <hip/hip_runtime.h>
#include <cstdio>
#include <cstdint>

#ifndef SPLIT_LAUNCHES
#define SPLIT_LAUNCHES 0
#endif
#ifndef K_ROT
#define K_ROT 1
#endif
#ifndef FP8_RES
#define FP8_RES 0xC
#endif
#ifndef LATE_CVT
#define LATE_CVT 1
#endif
#ifndef PROBE_EPI
#define PROBE_EPI 0
#endif
#ifndef DUP_MASK
#define DUP_MASK 0u
#endif
#ifndef FP8_GU
#define FP8_GU 0xE
#endif
#ifndef FP8_DN
#define FP8_DN 0xE
#endif
#ifndef FP8_QKV2
#define FP8_QKV2 1
#endif
#ifndef FP8_QKV1
#define FP8_QKV1 1
#endif
#ifndef FP8_WIN
#define FP8_WIN 0x0
#endif
#define F8GU(L) ((((FP8_GU) >> (L)) & 1) != 0)
#define F8DN(L) ((((FP8_DN) >> (L)) & 1) != 0)
#ifndef FP8_QKVD
#define FP8_QKVD 1
#endif
#ifndef FP8_ATTN
#define FP8_ATTN 1
#endif
#ifndef GEMM_STAGGER
#define GEMM_STAGGER 0
#endif
#ifndef PHASE_LIMIT
#define PHASE_LIMIT 1000
#endif

#define LAS __attribute__((address_space(3)))
typedef unsigned short bf16_t;
typedef short bf16x8 __attribute__((ext_vector_type(8)));
typedef short s16x4 __attribute__((ext_vector_type(4)));
typedef float f32x4 __attribute__((ext_vector_type(4)));
typedef float f32x2 __attribute__((ext_vector_type(2)));
typedef float f32x16 __attribute__((ext_vector_type(16)));
typedef unsigned u32x4 __attribute__((ext_vector_type(4)));
typedef unsigned u32x2 __attribute__((ext_vector_type(2)));

constexpr int DM = 1024, NBATCH = 8, SEQ = 8192, MT = NBATCH * SEQ;
constexpr int DFF = 3584, NEXP = 8;
constexpr int RG_L = 64, RG_NCH = SEQ / RG_L;
constexpr int DIL_CB = 2, DIL_ROWS = DIL_CB * SEQ, DIL_N = 9216;
constexpr float EPS = 1e-6f;
constexpr int NWG = 256;

constexpr size_t MiB = 1024 * 1024;
constexpr size_t WS_CTL   = 0;
constexpr size_t WS_TCNT  = 65536;
constexpr size_t WS_META  = WS_TCNT + 16384;
constexpr size_t WS_TOPE  = WS_META + 8192;
constexpr size_t WS_TOPG  = WS_TOPE + (size_t)MT * 8;
constexpr size_t WS_LRANK = WS_TOPG + (size_t)MT * 8;
constexpr int    SROWS    = 2 * MT + 16 * 256;
constexpr size_t WS_SIDX  = WS_LRANK + (size_t)MT * 8;
constexpr size_t WS_SGATE = WS_SIDX + (size_t)SROWS * 4;
constexpr size_t WS_SRS   = WS_SGATE + (size_t)SROWS * 4;
constexpr size_t WS_SUMP  = WS_SRS + (size_t)SROWS * 4;
constexpr size_t RG_SUMB  = (size_t)NBATCH * RG_NCH * 2 * 1024 * 4;
constexpr size_t WS_SUMH  = WS_SUMP + RG_SUMB;
constexpr size_t WS_CARRY = WS_SUMH + RG_SUMB;
constexpr size_t WS_LSE   = WS_CARRY + RG_SUMB;
constexpr size_t WS_T1    = WS_LSE + (size_t)3 * DIL_ROWS * 8 * 4;
constexpr size_t WS_T2    = WS_T1 + (size_t)128 * 32 * 8;
constexpr size_t WS_SS    = WS_T2 + (size_t)SEQ * 16 * 8;
constexpr size_t WS_WB    = (WS_SS + (size_t)2 * MT * 64 + 4095) & ~(size_t)4095;
constexpr size_t E_WIN = (size_t)2048 * 1024, E_GATE = (size_t)2 * 2 * 8 * 128 * 128, E_WOUT = (size_t)1024 * 1024, E_WGU = (size_t)7168 * 1024, E_WD = (size_t)1024 * 3584;
constexpr size_t E_QKV1 = (size_t)1536 * 1024, E_QKV2 = (size_t)9216 * 1024;
constexpr size_t O_L0_WIN = 0, O_L0_GATE = O_L0_WIN + E_WIN, O_L0_WOUT = O_L0_GATE + E_GATE, O_L0_WGU = O_L0_WOUT + E_WOUT, O_L0_WD = O_L0_WGU + E_WGU;
constexpr size_t O_L1_QKV = O_L0_WD + E_WD, O_L1_WOUT = O_L1_QKV + E_QKV1, O_L1_WGU = O_L1_WOUT + E_WOUT, O_L1_WD = O_L1_WGU + 8 * E_WGU;
constexpr size_t O_L2_QKV = O_L1_WD + 8 * E_WD, O_L2_WOUT = O_L2_QKV + E_QKV2, O_L2_WGU = O_L2_WOUT + E_WOUT, O_L2_WD = O_L2_WGU + E_WGU;
constexpr size_t O_L3_WIN = O_L2_WD + E_WD, O_L3_GATE = O_L3_WIN + E_WIN, O_L3_WOUT = O_L3_GATE + E_GATE, O_L3_WGU = O_L3_WOUT + E_WOUT, O_L3_WD = O_L3_WGU + 8 * E_WGU;
constexpr size_t E_WTOT = O_L3_WD + 8 * E_WD;
constexpr size_t WS_XB  = (WS_WB + E_WTOT * 2 + 4095) & ~(size_t)4095;
constexpr size_t WS_BIG = WS_XB + (size_t)MT * DM * 2;
constexpr size_t OUT_AO8 = (size_t)MT * DM * 3;
constexpr size_t OUT_X8 = (size_t)MT * DM * 2;
constexpr size_t BIG_BYTES = 496 * MiB;
constexpr size_t WS_END = WS_BIG + BIG_BYTES;
constexpr size_t BIG_OG = (size_t)DIL_ROWS * DIL_N * 2;
constexpr size_t BIG_HIDR = 224 * MiB;
constexpr size_t BIG_Y = 240 * MiB;
static_assert(BIG_HIDR + (size_t)8 * 256 * DFF * 2 <= BIG_Y && BIG_Y + (size_t)2 * MT * DM * 2 <= BIG_BYTES, "BIG map");
constexpr int LDS_GIX = 131072 + 256 + 16384;
constexpr int LDS_RSL = 131072 + 256;
constexpr int LDS_BYTES = 151552;
constexpr int LDS_BAR = 151552 - 256;

#define XB_TMO      128
#define XB_XCNT(j)  (256  + 64 * (j))
#define XB_XSUB(j)  (1280 + 64 * (j))
#define XB_XGEN(j)  (2304 + 64 * (j))
#define XB_TOP      3328
#define XB_TOPGEN   3392
#define XCD_BAR_WORDS 3456
#define XB_SPIN_CAP (1u << 18)
__device__ __forceinline__ unsigned xb_ld(unsigned* p)              { return __hip_atomic_load(p, __ATOMIC_RELAXED, __HIP_MEMORY_SCOPE_AGENT); }
__device__ __forceinline__ unsigned xb_add(unsigned* p, unsigned v) { return __hip_atomic_fetch_add(p, v, __ATOMIC_RELAXED, __HIP_MEMORY_SCOPE_AGENT); }
__device__ __forceinline__ unsigned xb_xcc_id() { return (unsigned)__builtin_amdgcn_s_getreg((3 << 11) | 20) & 0xFu; }
#define XB_SPIN(cond, bar) do { unsigned _sp = 0; while (cond) { __builtin_amdgcn_s_sleep(1); \
    if ((++_sp & 255u) == 0u) { if (xb_ld(&(bar)[XB_TMO])) break; if (_sp > XB_SPIN_CAP) { atomicAdd(&(bar)[XB_TMO], 1u); break; } } } } while (0)
struct XcdBarrier { unsigned* bar; unsigned x; volatile LAS unsigned* st; };
__device__ __forceinline__ int lane_id();
__device__ __forceinline__ XcdBarrier xcd_barrier_post(unsigned* bar, volatile LAS unsigned* st, bool t0) {
    XcdBarrier b; b.bar = bar; b.x = xb_xcc_id(); b.st = st;
    if (t0) (void)xb_add(&bar[XB_XCNT(b.x)], 1u);
    return b;
}
__device__ __forceinline__ void xcd_barrier_complete(unsigned* bar, unsigned x, unsigned& nloc, unsigned& nx) {
    const unsigned G = gridDim.x * gridDim.y * gridDim.z;
    unsigned sum, cnt, mine, sp = 0u;
    for (;;) {
        sum = 0u; cnt = 0u; mine = 0u;
#pragma unroll
        for (unsigned j = 0; j < 16; ++j) { const unsigned c = xb_ld(&bar[XB_XCNT(j)]); sum += c; cnt += (c > 0u) ? 1u : 0u; mine = (j == x) ? c : mine; }
        if (sum == G) break;
        __builtin_amdgcn_s_sleep(1);
        if ((++sp & 255u) == 0u) { if (xb_ld(&bar[XB_TMO])) break; if (sp > XB_SPIN_CAP) { atomicAdd(&bar[XB_TMO], 1u); break; } }
    }
    nloc = mine > 0u ? mine : 1u; nx = cnt > 0u ? cnt : 1u;
}
__device__ __forceinline__ void xcd_barrier(const XcdBarrier& b, bool t0) {
    asm volatile("s_waitcnt vmcnt(0)" ::: "memory");
    __syncthreads();
    if (t0) {
        unsigned* bar = b.bar;
        __builtin_amdgcn_s_waitcnt(0);
        unsigned nloc = b.st[0], nx = b.st[1];
        if (nloc == 0u) { xcd_barrier_complete(bar, b.x, nloc, nx); b.st[0] = nloc; b.st[1] = nx; }
        const unsigned old = xb_add(&bar[XB_XSUB(b.x)], 1u);
        const unsigned gen = old / nloc;
        if (old + 1u == (gen + 1u) * nloc) {
            __builtin_amdgcn_fence(__ATOMIC_RELEASE, "agent");
            asm volatile("s_waitcnt vmcnt(0)" ::: "memory");
            const unsigned og = xb_add(&bar[XB_TOP], 1u);
            const unsigned tg = og / nx;
            if (og + 1u == (tg + 1u) * nx) xb_add(&bar[XB_TOPGEN], 1u);
            else XB_SPIN(xb_ld(&bar[XB_TOPGEN]) == tg, bar);
            __builtin_amdgcn_fence(__ATOMIC_ACQUIRE, "agent");
            xb_add(&bar[XB_XGEN(b.x)], 1u);
            asm volatile("s_waitcnt vmcnt(0)" ::: "memory");
        } else {
            XB_SPIN(xb_ld(&bar[XB_XGEN(b.x)]) == gen, bar);
            __builtin_amdgcn_fence(__ATOMIC_ACQUIRE, "agent");
            asm volatile("s_waitcnt vmcnt(0)" ::: "memory");
        }
    }
    __syncthreads();
}

__device__ __forceinline__ int lane_id() { int l; asm volatile("v_mbcnt_lo_u32_b32 %0, -1, 0\n\tv_mbcnt_hi_u32_b32 %0, -1, %0" : "=v"(l)); return l; }
__device__ __forceinline__ int fresh_tid(int wv) { int w = wv; asm volatile("" : "+s"(w)); return (w << 6) | lane_id(); }
#define GAS __attribute__((address_space(1)))
template <class T> __device__ __forceinline__ T* fresh_ptr(T* p) { GAS T* q = (GAS T*)p; asm volatile("" : "+s"(q)); return (T*)q; }
__device__ __forceinline__ unsigned cvt_pk_bf16(float lo, float hi) { unsigned r; asm volatile("v_cvt_pk_bf16_f32 %0, %1, %2" : "=v"(r) : "v"(lo), "v"(hi)); return r; }
typedef int v8i __attribute__((ext_vector_type(8)));
typedef int i32x4 __attribute__((ext_vector_type(4)));
constexpr int F8S_HN = 1, F8S_WGU = 5, F8S_HID = 2, F8S_WD = 6, F8S_AO = 0;
constexpr int e8m0x4(int s) { return (127 - s) * 0x01010101; }
__device__ __forceinline__ unsigned cvt_pk4_fp8(float a, float b, float c, float d) {
    a = __builtin_amdgcn_fmed3f(a, -448.f, 448.f); b = __builtin_amdgcn_fmed3f(b, -448.f, 448.f); c = __builtin_amdgcn_fmed3f(c, -448.f, 448.f); d = __builtin_amdgcn_fmed3f(d, -448.f, 448.f);
    int w = 0; w = __builtin_amdgcn_cvt_pk_fp8_f32(a, b, w, false); w = __builtin_amdgcn_cvt_pk_fp8_f32(c, d, w, true); return (unsigned)w;
}
__device__ __forceinline__ float bf2f(short s) { return __uint_as_float(((unsigned)(unsigned short)s) << 16); }
__device__ __forceinline__ float shfl_xor_l(float v, int m, int lane) { return __int_as_float(__builtin_amdgcn_ds_bpermute((lane ^ m) << 2, __float_as_int(v))); }
template <int CTRL> __device__ __forceinline__ float dpp_mov(float v) { return __int_as_float(__builtin_amdgcn_update_dpp(0, __float_as_int(v), CTRL, 0xf, 0xf, true)); }
__device__ __forceinline__ float row16_sum(float v) { v += dpp_mov<0xB1>(v); v += dpp_mov<0x4E>(v); v += dpp_mov<0x141>(v); v += dpp_mov<0x140>(v); return v; }
__device__ __forceinline__ float wave_sum(float v, int lane) {
    v = row16_sum(v); v += shfl_xor_l(v, 16, lane); v += shfl_xor_l(v, 32, lane);
    return v;
}
__device__ __forceinline__ float silu_f(float g) { return g * __builtin_amdgcn_rcpf(1.0f + __builtin_amdgcn_exp2f(-1.4426950408889634f * g)); }
__device__ __forceinline__ float sigmoid_f(float g) { return __builtin_amdgcn_rcpf(1.0f + __builtin_amdgcn_exp2f(-1.4426950408889634f * g)); }
__device__ __forceinline__ float gelu_tanh_f(float x) {
    const float z = x * (1.0f + 0.044715f * x * x);
    return x * __builtin_amdgcn_rcpf(1.0f + __builtin_amdgcn_exp2f(-2.0f * 0.7978845608028654f * 1.4426950408889634f * z));
}

namespace pg8 {
constexpr int BM = 256, BK = 64, HALF = 128, HTB = HALF * BK * 2, STAGE_BYTES = 8 * HTB, NXCD = 8, WGM = 8;
__host__ __device__ __forceinline__ int lds_byte(int r, int c) { const int st = (r >> 4) * 2 + (c >> 5), rr = r & 15, cc = c & 31, ob = rr * 64 + cc * 2; return st * 1024 + (ob ^ (((ob >> 9) & 1) << 5)); }
__host__ __device__ __forceinline__ void stage_rc(int b, int& R, int& C) { const int st = b / 1024, sb = b % 1024, swz = sb ^ (((sb >> 9) & 1) << 5); R = (st >> 1) * 16 + swz / 64; C = (st & 1) * 32 + (swz % 64) / 2; }
__host__ __device__ __forceinline__ int perm32(int rho) { const int n = rho >> 4, i = rho & 15; return 8 * (i >> 2) + 4 * n + (i & 3); }

struct Unit { int pm, pn, e; };
struct Sched {
    const char* A; const char* B; size_t b_estride; const int* tile_e; const int* gidx;
    int nM, nN, G, c, t0;
    int a_tm;
    const char* rs;
    const char* rs2;
    int hot;
    __device__ __forceinline__ bool next(int i, Unit& u) const {
        const int nwg = nM * nN; const long L = (long)i * G + c; if (L >= nwg) return false;
        int wgid = (int)L; { const int q = nwg / NXCD, r = nwg % NXCD, xcd = wgid % NXCD, off = wgid / NXCD; wgid = (xcd < r ? xcd * (q + 1) : r * (q + 1) + (xcd - r) * q) + off; }
        const int nig = WGM * nN, gid = wgid / nig, fm = gid * WGM, gsz = (nM - fm) < WGM ? (nM - fm) : WGM;
        u.pm = fm + ((wgid % nig) % gsz); u.pn = (wgid % nig) / gsz;
        u.e = 0;
        return true;
    }
};

typedef float ss_t;
__device__ __forceinline__ float ss_row(const ss_t* ss, int row) { const f32x4* p = (const f32x4*)(ss + (size_t)row * 16); const f32x4 a = p[0], b = p[1], c = p[2], d = p[3];
    return (((a[0] + a[1]) + (a[2] + a[3])) + ((b[0] + b[1]) + (b[2] + b[3]))) + (((c[0] + c[1]) + (c[2] + c[3])) + ((d[0] + d[1]) + (d[2] + d[3]))); }
__device__ __forceinline__ float rstd_of(const ss_t* ss, int row) { return 1.0f / sqrtf(ss_row(ss, row) * (1.0f / DM) + EPS); }
__device__ __forceinline__ float rs_lds(const LAS unsigned char* rsl, int mode, int lr) {
    if (mode == 1) return *(const LAS float*)(rsl + lr * 64);
    return *(const LAS float*)(rsl + lr * 4); }
__device__ __forceinline__ void rs_reduce_lds(LAS unsigned char* rsl, int row) {
    const LAS f32x4* p = (const LAS f32x4*)(rsl + row * 64); const f32x4 a = p[0], b = p[1], c = p[2], d = p[3];
    const float t = (((a[0] + a[1]) + (a[2] + a[3])) + ((b[0] + b[1]) + (b[2] + b[3]))) + (((c[0] + c[1]) + (c[2] + c[3])) + ((d[0] + d[1]) + (d[2] + d[3])));
    *(LAS float*)(rsl + row * 64) = __builtin_amdgcn_rsqf(t * (1.0f / DM) + EPS);
}
struct EpiResid {
    static constexpr bool PERM = true; static constexpr int RSMODE = 0;
    bf16_t* X; ss_t* ss_out; int row0; unsigned char* x8;
    __device__ __forceinline__ void operator()(const f32x4 (&acc)[2][2][4][2], const Unit& u, int wr, int wc, int fr, int fq, const LAS unsigned char*) const {
        const int r0 = row0 + u.pm * BM + wr * 64 + fr, c0 = u.pn * BM + wc * 32 + 8 * fq; const int lane = fr + 16 * fq;
#pragma unroll
        for (int ai = 0; ai < 2; ++ai) {
            u32x4 xb[4][2];
#pragma unroll
            for (int m = 0; m < 4; ++m)
#pragma unroll
                for (int bj = 0; bj < 2; ++bj) xb[m][bj] = *(const u32x4*)(X + (size_t)(r0 + ai * HALF + m * 16) * DM + c0 + bj * HALF);
            asm volatile("" ::: "memory");
#pragma unroll
            for (int m = 0; m < 4; ++m) { const int row = r0 + ai * HALF + m * 16; bf16_t* xp = X + (size_t)row * DM + c0; float sq = 0.f;
#pragma unroll
                for (int bj = 0; bj < 2; ++bj) { const u32x4 b = xb[m][bj]; const f32x4 a0 = acc[ai][bj][m][0], a1 = acc[ai][bj][m][1];
                    float v[8];
                    v[0] = __uint_as_float(b.x << 16) + a0[0]; v[1] = __uint_as_float(b.x & 0xffff0000u) + a0[1]; v[2] = __uint_as_float(b.y << 16) + a0[2]; v[3] = __uint_as_float(b.y & 0xffff0000u) + a0[3];
                    v[4] = __uint_as_float(b.z << 16) + a1[0]; v[5] = __uint_as_float(b.z & 0xffff0000u) + a1[1]; v[6] = __uint_as_float(b.w << 16) + a1[2]; v[7] = __uint_as_float(b.w & 0xffff0000u) + a1[3];
#pragma unroll
                    for (int j = 0; j < 8; ++j) sq += v[j] * v[j];
                    u32x4 w; w.x = cvt_pk_bf16(v[0], v[1]); w.y = cvt_pk_bf16(v[2], v[3]); w.z = cvt_pk_bf16(v[4], v[5]); w.w = cvt_pk_bf16(v[6], v[7]);
                    *(u32x4*)(xp + bj * HALF) = w;
                    if (x8) { constexpr float sc = (float)(1 << F8S_HN); u32x2 q; q.x = cvt_pk4_fp8(v[0] * sc, v[1] * sc, v[2] * sc, v[3] * sc); q.y = cvt_pk4_fp8(v[4] * sc, v[5] * sc, v[6] * sc, v[7] * sc);
                        *(u32x2*)(x8 + (size_t)row * DM + c0 + bj * HALF) = q; } }
                sq += shfl_xor_l(sq, 16, lane); sq += shfl_xor_l(sq, 32, lane);
                if (fq == 0) ss_out[(size_t)row * 16 + u.pn * 4 + wc] = sq; }
        }
    }
};
struct EpiMoeY {
    static constexpr bool PERM = true; static constexpr int RSMODE = 3;
    bf16_t* Y;
    __device__ __forceinline__ void operator()(const f32x4 (&acc)[2][2][4][2], const Unit& u, int wr, int wc, int fr, int fq, const LAS unsigned char* rsl) const {
        const int c0 = u.pn * BM + wc * 32 + 8 * fq;
#pragma unroll
        for (int ai = 0; ai < 2; ++ai)
#pragma unroll
            for (int m = 0; m < 4; ++m) { const int lr = wr * 64 + fr + ai * HALF + m * 16; const int v = *(const LAS int*)(rsl + lr * 4);
                if (v >= 0) { const float g = *(const LAS float*)(rsl + 1024 + lr * 4); bf16_t* yp = Y + ((size_t)(v >> 20) * MT + (size_t)(v & 0xFFFFF)) * DM + c0;
#pragma unroll
                    for (int bj = 0; bj < 2; ++bj) { const f32x4 v0 = g * acc[ai][bj][m][0], v1 = g * acc[ai][bj][m][1];
                        u32x4 w; w.x = cvt_pk_bf16(v0[0], v0[1]); w.y = cvt_pk_bf16(v0[2], v0[3]); w.z = cvt_pk_bf16(v1[0], v1[1]); w.w = cvt_pk_bf16(v1[2], v1[3]);
                        *(u32x4*)(yp + bj * HALF) = w; } } }
    }
};
template <bool F8OUT, int RSM>
struct EpiSwiglu {
    static constexpr bool PERM = true; static constexpr int RSMODE = RSM;
    void* H;
    __device__ __forceinline__ void operator()(const f32x4 (&acc)[2][2][4][2], const Unit& u, int wr, int wc, int fr, int fq, const LAS unsigned char* rsl) const {
#pragma unroll
        for (int ai = 0; ai < 2; ++ai)
#pragma unroll
            for (int m = 0; m < 4; ++m) { const float rs = rs_lds(rsl, RSM, wr * 64 + fr + ai * HALF + m * 16);
                const f32x4 g0 = acc[ai][0][m][0], g1 = acc[ai][0][m][1], u0 = acc[ai][1][m][0], u1 = acc[ai][1][m][1];
                const float eb = -1.4426950408889634f * rs, ik2 = __builtin_amdgcn_rcpf(rs * rs * (F8OUT ? (float)(1 << F8S_HID) : 1.0f));
                float h[8];
#pragma unroll
                for (int j = 0; j < 4; j += 2) {
                    { const f32x2 G = {g0[j], g0[j + 1]}, U = {u0[j], u0[j + 1]}; const f32x2 T = G * eb; f32x2 D = {__builtin_amdgcn_exp2f(T[0]), __builtin_amdgcn_exp2f(T[1])}; D = D * ik2 + ik2;
                      const f32x2 R = {__builtin_amdgcn_rcpf(D[0]), __builtin_amdgcn_rcpf(D[1])}; const f32x2 H = (G * U) * R; h[j] = H[0]; h[j + 1] = H[1]; }
                    { const f32x2 G = {g1[j], g1[j + 1]}, U = {u1[j], u1[j + 1]}; const f32x2 T = G * eb; f32x2 D = {__builtin_amdgcn_exp2f(T[0]), __builtin_amdgcn_exp2f(T[1])}; D = D * ik2 + ik2;
                      const f32x2 R = {__builtin_amdgcn_rcpf(D[0]), __builtin_amdgcn_rcpf(D[1])}; const f32x2 H = (G * U) * R; h[4 + j] = H[0]; h[4 + j + 1] = H[1]; } }
                const int lrow = wr * 64 + fr + ai * HALF + m * 16;
                if (F8OUT) { u32x2 w; w.x = cvt_pk4_fp8(h[0], h[1], h[2], h[3]); w.y = cvt_pk4_fp8(h[4], h[5], h[6], h[7]);
                    *(u32x2*)((unsigned char*)H + (((size_t)u.pm * (DFF / 128) + u.pn) * 256 + lrow) * 128 + wc * 32 + 8 * fq) = w; }
                else { u32x4 w; w.x = cvt_pk_bf16(h[0], h[1]); w.y = cvt_pk_bf16(h[2], h[3]); w.z = cvt_pk_bf16(h[4], h[5]); w.w = cvt_pk_bf16(h[6], h[7]);
                    *(u32x4*)((unsigned char*)H + (((size_t)u.pm * (DFF / 64) + 2 * u.pn + (wc >> 1)) * 256 + lrow) * 128 + (wc & 1) * 64 + 16 * fq) = w; } }
    }
};
struct EpiWin {
    static constexpr bool PERM = true; static constexpr int RSMODE = 1;
    bf16_t* GY; bf16_t* XBR;
    __device__ __forceinline__ void operator()(const f32x4 (&acc)[2][2][4][2], const Unit& u, int wr, int wc, int fr, int fq, const LAS unsigned char* rsl) const {
        const bool isy = u.pn < 4; bf16_t* O = isy ? GY : XBR;
        const int r0 = u.pm * BM + wr * 64 + fr, c0 = (u.pn & 3) * BM + wc * 32 + 8 * fq;
#pragma unroll
        for (int ai = 0; ai < 2; ++ai)
#pragma unroll
            for (int m = 0; m < 4; ++m) { const float rs = rs_lds(rsl, 1, wr * 64 + fr + ai * HALF + m * 16);
#pragma unroll
                for (int bj = 0; bj < 2; ++bj) { f32x4 v0 = acc[ai][bj][m][0] * rs, v1 = acc[ai][bj][m][1] * rs;
                    if (isy) {
                        constexpr float c1 = -2.0f * 0.7978845608028654f * 1.4426950408889634f, c2 = c1 * 0.044715f;
#pragma unroll
                        for (int j = 0; j < 4; j += 2) {
                            { const f32x2 X = {v0[j], v0[j + 1]}; const f32x2 T = X * ((X * X) * c2 + c1); const f32x2 D = (f32x2){__builtin_amdgcn_exp2f(T[0]), __builtin_amdgcn_exp2f(T[1])} + 1.0f;
                              const f32x2 Y = X * (f32x2){__builtin_amdgcn_rcpf(D[0]), __builtin_amdgcn_rcpf(D[1])}; v0[j] = Y[0]; v0[j + 1] = Y[1]; }
                            { const f32x2 X = {v1[j], v1[j + 1]}; const f32x2 T = X * ((X * X) * c2 + c1); const f32x2 D = (f32x2){__builtin_amdgcn_exp2f(T[0]), __builtin_amdgcn_exp2f(T[1])} + 1.0f;
                              const f32x2 Y = X * (f32x2){__builtin_amdgcn_rcpf(D[0]), __builtin_amdgcn_rcpf(D[1])}; v1[j] = Y[0]; v1[j + 1] = Y[1]; } } }
                    u32x4 w; w.x = cvt_pk_bf16(v0[0], v0[1]); w.y = cvt_pk_bf16(v0[2], v0[3]); w.z = cvt_pk_bf16(v1[0], v1[1]); w.w = cvt_pk_bf16(v1[2], v1[3]);
                    *(u32x4*)(O + (size_t)(r0 + ai * HALF + m * 16) * DM + c0 + bj * HALF) = w; } }
    }
};
struct EpiBf16 {
    static constexpr bool PERM = true; static constexpr int RSMODE = 1;
    bf16_t* O; int ldc;
    __device__ __forceinline__ void operator()(const f32x4 (&acc)[2][2][4][2], const Unit& u, int wr, int wc, int fr, int fq, const LAS unsigned char* rsl) const {
        const int r0 = u.pm * BM + wr * 64 + fr, c0 = u.pn * BM + wc * 32 + 8 * fq;
#pragma unroll
        for (int ai = 0; ai < 2; ++ai)
#pragma unroll
            for (int m = 0; m < 4; ++m) { const float rs = rs_lds(rsl, 1, wr * 64 + fr + ai * HALF + m * 16);
#pragma unroll
                for (int bj = 0; bj < 2; ++bj) { const f32x4 v0 = acc[ai][bj][m][0] * rs, v1 = acc[ai][bj][m][1] * rs;
                    if (ldc < 0) { u32x2 q; q.x = cvt_pk4_fp8(v0[0] * 4.f, v0[1] * 4.f, v0[2] * 4.f, v0[3] * 4.f); q.y = cvt_pk4_fp8(v1[0] * 4.f, v1[1] * 4.f, v1[2] * 4.f, v1[3] * 4.f);
                        *(u32x2*)((unsigned char*)O + (size_t)(r0 + ai * HALF + m * 16) * (size_t)(-ldc) + c0 + bj * HALF) = q; }
                    else { u32x4 w; w.x = cvt_pk_bf16(v0[0], v0[1]); w.y = cvt_pk_bf16(v0[2], v0[3]); w.z = cvt_pk_bf16(v1[0], v1[1]); w.w = cvt_pk_bf16(v1[2], v1[3]);
                        *(u32x4*)(O + (size_t)(r0 + ai * HALF + m * 16) * ldc + c0 + bj * HALF) = w; } } }
    }
};

#if PROBE_EPI
template <int RSM> struct EpiNull {
    static constexpr bool PERM = true; static constexpr int RSMODE = RSM;
    __device__ __forceinline__ void operator()(const f32x4 (&acc)[2][2][4][2], const Unit&, int, int, int, int, const LAS unsigned char*) const {
#pragma unroll
        for (int a = 0; a < 2; ++a)
#pragma unroll
            for (int b = 0; b < 2; ++b)
#pragma unroll
                for (int m = 0; m < 4; ++m)
#pragma unroll
                    for (int n = 0; n < 2; ++n) asm volatile("" :: "v"(acc[a][b][m][n]));
    }
};
#endif
template <class Epi, bool GATHER, int F8SW = 0, int F8SA = 0>
__device__ __forceinline__ void gemm_phase(LAS unsigned char* lds, const int K, const Sched& S, const Epi& E, int wv) {
    constexpr bool FP8 = F8SW != 0; constexpr int ES = FP8 ? 1 : 2;
    const int tid = fresh_tid(wv), wid = __builtin_amdgcn_readfirstlane(tid >> 6), lane = tid & 63, wr = wid >> 2, wc = wid & 3, fr = lane & 15, fq = lane >> 4;
    const int nt = K / (FP8 ? 2 * BK : BK);
    unsigned voffB[2];
#pragma unroll
    for (int i = 0; i < 2; ++i) { int R, C; stage_rc(tid * 16 + i * 8192, R, C); const int Rb = Epi::PERM ? ((R & ~31) + perm32(R & 31)) : R; voffB[i] = (unsigned)(Rb * K * ES + C * 2); }
    const size_t kstep = (size_t)(BK * 2);
    const size_t hstep = (size_t)HALF * K * ES;
    const size_t tstep = 2 * hstep;
    const bool atm = !GATHER && S.a_tm != 0;
    const int arow = atm ? 128 : K * ES;
    const size_t kstepA = atm ? (size_t)32768 : kstep, hstepA = (size_t)HALF * arow, tstepA = atm ? (size_t)nt * 32768 : tstep;
    const unsigned ldsw = (unsigned)wid * 1024u;
    const int aoff = lds_byte(wr * 64 + fr, fq * 8), boff = lds_byte(wc * 32 + fr, fq * 8);
    unsigned voffA[2][2];
#define PG8_SETV(V, U) do { _Pragma("unroll") for (int _h = 0; _h < (GATHER ? 2 : 1); ++_h) _Pragma("unroll") for (int _i = 0; _i < 2; ++_i) { int _R, _C; stage_rc((fresh_tid(wv)) * 16 + _i * 8192, _R, _C); \
        if (GATHER) { int _g = S.gidx[(size_t)(S.t0 + ((PROBE_EPI == 4 || PROBE_EPI == 5) && S.hot ? 0 : (U).pm)) * BM + _h * HALF + _R]; _g = _g < 0 ? 0 : (_g & 0xFFFFF); V[_h][_i] = (unsigned)_g * (unsigned)(K * ES) + (unsigned)(_C * 2); } \
        else V[_h][_i] = (unsigned)(_R * arow + _C * 2); } } while (0)
#define PG8_ABASE(U) (GATHER ? S.A : S.A + (size_t)((PROBE_EPI == 4 || PROBE_EPI == 5) && S.hot ? 0 : (U).pm) * tstepA)
#define PG8_BBASE(U) (S.B + (size_t)(U).e * S.b_estride + (size_t)((PROBE_EPI == 4 || PROBE_EPI == 5) && S.hot ? 0 : (U).pn) * tstep)
#define PG8_SA(b, h) (((b) * 2 + (h)) * HTB)
#define PG8_SB(b, h) ((4 + (b) * 2 + (h)) * HTB)
#define PG8_STAGE(bufoff, gbase, voff) do { _Pragma("unroll") for (int _i = 0; _i < 2; ++_i) \
        __builtin_amdgcn_global_load_lds((const unsigned*)((const char*)(gbase) + (voff)[_i]), (LAS unsigned*)(lds + (bufoff) + ldsw + _i * 8192), 16, 0, 0); } while (0)
#define PG8_STAGE_A(bufoff, gbase, h) do { if (GATHER) PG8_STAGE(bufoff, gbase, voffA[h]); else PG8_STAGE(bufoff, (gbase) + (h) * hstepA, voffA[0]); } while (0)
#define PG8_LDA(dst, b, h) do { _Pragma("unroll") for (int m = 0; m < 4; ++m) _Pragma("unroll") for (int k = 0; k < 2; ++k) dst[m][k] = *(const LAS bf16x8*)(lds + PG8_SA(b, h) + aoff + m * 2048 + k * 1024); } while (0)
#define PG8_LDB(dst, b, h) do { _Pragma("unroll") for (int n = 0; n < 2; ++n) _Pragma("unroll") for (int k = 0; k < 2; ++k) dst[n][k] = *(const LAS bf16x8*)(lds + PG8_SB(b, h) + boff + n * 2048 + k * 1024); } while (0)
#define PG8_CAT(X) __builtin_shufflevector(__builtin_bit_cast(i32x4, (X)[0]), __builtin_bit_cast(i32x4, (X)[1]), 0, 1, 2, 3, 4, 5, 6, 7)
#define PG8_MMA(ai, bj, At, Bt) do { __builtin_amdgcn_s_setprio(1); \
        if (FP8) { _Pragma("unroll") for (int m = 0; m < 4; ++m) _Pragma("unroll") for (int n = 0; n < 2; ++n) \
            asm volatile("v_mfma_scale_f32_16x16x128_f8f6f4 %0, %1, %2, %0, %3, %4 op_sel_hi:[0,0,0]" : "+v"(acc[ai][bj][m][n]) : "v"(PG8_CAT(Bt[n])), "v"(PG8_CAT(At[m])), "v"(f8sw), "v"(f8sa)); } \
        else { _Pragma("unroll") for (int m = 0; m < 4; ++m) _Pragma("unroll") for (int n = 0; n < 2; ++n) _Pragma("unroll") for (int k = 0; k < 2; ++k) \
            acc[ai][bj][m][n] = __builtin_amdgcn_mfma_f32_16x16x32_bf16(Bt[n][k], At[m][k], acc[ai][bj][m][n], 0, 0, 0); } \
        __builtin_amdgcn_s_setprio(0); } while (0)
#define PG8_WAIT_V(n) asm volatile("s_waitcnt vmcnt(" #n ")" ::: "memory")
#define PG8_WAIT_L(n) asm volatile("s_waitcnt lgkmcnt(" #n ")" ::: "memory")
#define PG8_BAR __builtin_amdgcn_s_barrier()
#define PG8_SCHED __builtin_amdgcn_sched_barrier(0)
    int tb0 = 0x7fffffff, tb1 = 0x7fffffff, tb2 = 0x7fffffff, tb3 = 0x7fffffff, tb4 = 0x7fffffff, tb5 = 0x7fffffff, tb6 = 0x7fffffff;
    if (S.tile_e) { tb0 = __builtin_amdgcn_readfirstlane(S.tile_e[1]) >> 8; tb1 = __builtin_amdgcn_readfirstlane(S.tile_e[2]) >> 8; tb2 = __builtin_amdgcn_readfirstlane(S.tile_e[3]) >> 8; tb3 = __builtin_amdgcn_readfirstlane(S.tile_e[4]) >> 8;
        tb4 = __builtin_amdgcn_readfirstlane(S.tile_e[5]) >> 8; tb5 = __builtin_amdgcn_readfirstlane(S.tile_e[6]) >> 8; tb6 = __builtin_amdgcn_readfirstlane(S.tile_e[7]) >> 8; }
#define PG8_EXPERT(U) do { const int _t = S.t0 + (U).pm; (U).e = __builtin_amdgcn_readfirstlane((_t >= tb0) + (_t >= tb1) + (_t >= tb2) + (_t >= tb3) + (_t >= tb4) + (_t >= tb5) + (_t >= tb6)); } while (0)
    const int kmask = (K_ROT && (nt & (nt - 1)) == 0) ? nt - 1 : 0x7fffffff;
    const int rot = (K_ROT && (nt & (nt - 1)) == 0) ? ((__builtin_amdgcn_readfirstlane(S.c >> 3) * 2) & kmask) : 0;
#define PG8_KT(i) (((i) + rot) & kmask)
    Unit cur, nxt; int ui = 0;
    if (!S.next(0, cur)) return;
    PG8_EXPERT(cur);
    if (GEMM_STAGGER) { const int dly = (S.c & 7) * GEMM_STAGGER; for (int i = 0; i < dly; ++i) __builtin_amdgcn_s_sleep(8); }
    const int f8sw = F8SW, f8sa = F8SA;
    f32x4 acc[2][2][4][2];
#pragma unroll
    for (int a = 0; a < 2; ++a)
#pragma unroll
        for (int b = 0; b < 2; ++b)
#pragma unroll
            for (int m = 0; m < 4; ++m)
#pragma unroll
                for (int n = 0; n < 2; ++n) acc[a][b][m][n] = (f32x4){0.f, 0.f, 0.f, 0.f};
    bf16x8 At[4][2], B0[2][2], B1[2][2];
    const char* cA = PG8_ABASE(cur); const char* cB = PG8_BBASE(cur);
    constexpr int RSM = Epi::RSMODE;
#define PG8_RSDMA(U) do { if (RSM == 1) { _Pragma("unroll") for (int _i = 0; _i < 2; ++_i) __builtin_amdgcn_global_load_lds((const unsigned*)(S.rs + (size_t)(U).pm * 16384 + (unsigned)(fresh_tid(wv) * 16 + _i * 8192)), (LAS unsigned*)(lds + LDS_RSL + ldsw + _i * 8192), 16, 0, 0); } \
        else if (RSM == 2) { if (wid < 4) __builtin_amdgcn_global_load_lds((const unsigned*)(S.rs + (size_t)(S.t0 + (U).pm) * 1024 + (unsigned)(fresh_tid(wv) * 4)), (LAS unsigned*)(lds + LDS_RSL + ldsw / 4), 4, 0, 0); } \
        else if (RSM == 3) { __builtin_amdgcn_global_load_lds((const unsigned*)((wid < 4 ? S.rs : S.rs2) + (size_t)(S.t0 + (U).pm) * 1024 + (unsigned)((fresh_tid(wv) & 255) * 4)), (LAS unsigned*)(lds + LDS_RSL + ldsw / 4), 4, 0, 0); } } while (0)
#pragma unroll
    for (int h = 0; h < 2; ++h) { voffA[h][0] = 0u; voffA[h][1] = 0u; }
    PG8_SETV(voffA, cur);
    if (GATHER) { asm volatile("s_waitcnt vmcnt(0)" ::: "memory"); }
    { const char* pA = cA + (size_t)rot * kstepA; const char* pB = cB + (size_t)rot * kstep;
    PG8_STAGE(PG8_SB(0, 0), pB, voffB); PG8_STAGE_A(PG8_SA(0, 0), pA, 0); PG8_STAGE(PG8_SB(0, 1), pB + hstep, voffB); PG8_STAGE_A(PG8_SA(0, 1), pA, 1);
    if (wr == 1) PG8_BAR;
    PG8_WAIT_V(4); PG8_BAR;
    PG8_STAGE(PG8_SB(1, 0), pB + kstep, voffB); PG8_STAGE_A(PG8_SA(1, 0), pA + kstepA, 0); PG8_STAGE(PG8_SB(1, 1), pB + hstep + kstep, voffB); }
    PG8_WAIT_V(6); PG8_BAR;
    for (;;) {
        const bool has_next = S.next(ui + 1, nxt);
        if (has_next) PG8_EXPERT(nxt);
        const char* nA = has_next ? PG8_ABASE(nxt) : cA; const char* nB = has_next ? PG8_BBASE(nxt) : cB;
#pragma unroll 1
        for (int t = 0; t < nt; t += 2) {
            const bool last = (t == nt - 2);
            const char* a1 = cA + (size_t)(PG8_KT(t) + 1) * kstepA;
            const char* a2 = last ? nA + (size_t)rot * kstepA : cA + (size_t)PG8_KT(t + 2) * kstepA; const char* b2 = last ? nB + (size_t)rot * kstep : cB + (size_t)PG8_KT(t + 2) * kstep;
            const char* a3 = a2 + kstepA; const char* b3 = b2 + kstep;
            asm volatile("" : "+s"(a1), "+s"(a2), "+s"(a3), "+s"(b2), "+s"(b3));
            PG8_LDB(B0, 0, 0); PG8_SCHED; PG8_LDA(At, 0, 0); PG8_STAGE_A(PG8_SA(1, 1), a1, 1);
            if (GATHER) { if (last && has_next) { _Pragma("unroll") for (int _h = 0; _h < 2; ++_h) _Pragma("unroll") for (int _i = 0; _i < 2; ++_i) { int _R, _C; stage_rc((fresh_tid(wv)) * 16 + _i * 8192, _R, _C);
                    int _g = *(const LAS int*)(lds + LDS_GIX + (_h * HALF + _R) * 4); _g = _g < 0 ? 0 : (_g & 0xFFFFF); voffA[_h][_i] = (unsigned)_g * (unsigned)(K * ES) + (unsigned)(_C * 2); } } }
            PG8_WAIT_L(8); PG8_BAR; PG8_WAIT_L(0); PG8_MMA(0, 0, At, B0); PG8_BAR; PG8_SCHED;
            PG8_LDB(B1, 0, 1); PG8_STAGE(PG8_SB(0, 0), b2, voffB);
            PG8_BAR; PG8_WAIT_L(0); PG8_MMA(0, 1, At, B1); PG8_BAR;
            PG8_LDA(At, 0, 1); PG8_STAGE_A(PG8_SA(0, 0), a2, 0);
            if (RSM != 0) { if (t == 0) PG8_RSDMA(cur); }
            if (GATHER) { if (t == 0 && has_next && wid < 4) __builtin_amdgcn_global_load_lds((const unsigned*)(S.gidx + (size_t)(S.t0 + ((PROBE_EPI == 4 || PROBE_EPI == 5) && S.hot ? 0 : nxt.pm)) * BM + fresh_tid(wv)), (LAS unsigned*)(lds + LDS_GIX + ldsw / 4), 4, 0, 0); }
            PG8_BAR; PG8_WAIT_L(0); PG8_MMA(1, 0, At, B0); PG8_BAR; PG8_SCHED;
            PG8_STAGE(PG8_SB(0, 1), b2 + hstep, voffB);
            if (RSM == 1) { if (t == 2 && wid < 4) rs_reduce_lds(lds + LDS_RSL, fresh_tid(wv)); }
            PG8_WAIT_V(6); PG8_BAR; PG8_MMA(1, 1, At, B1); PG8_BAR;
            PG8_LDB(B0, 1, 0); PG8_SCHED; PG8_LDA(At, 1, 0); PG8_STAGE_A(PG8_SA(0, 1), a2, 1);
            PG8_WAIT_L(8); PG8_BAR; PG8_WAIT_L(0); PG8_MMA(0, 0, At, B0); PG8_BAR; PG8_SCHED;
            PG8_LDB(B1, 1, 1); PG8_STAGE(PG8_SB(1, 0), b3, voffB);
            PG8_BAR; PG8_WAIT_L(0); PG8_MMA(0, 1, At, B1); PG8_BAR;
            PG8_LDA(At, 1, 1); PG8_STAGE_A(PG8_SA(1, 0), a3, 0);
            PG8_BAR; PG8_WAIT_L(0); PG8_MMA(1, 0, At, B0); PG8_BAR; PG8_SCHED;
            PG8_STAGE(PG8_SB(1, 1), b3 + hstep, voffB);
            PG8_WAIT_V(6); PG8_BAR; PG8_MMA(1, 1, At, B1); PG8_BAR;
        }
        if (FP8) asm volatile("s_nop 15\n\ts_nop 15" ::: "memory");
        { const int l2 = lane_id(); E(acc, cur, wr, wc, l2 & 15, l2 >> 4, lds + LDS_RSL); }
        if (!has_next) break;
#pragma unroll
        for (int a = 0; a < 2; ++a)
#pragma unroll
            for (int b = 0; b < 2; ++b)
#pragma unroll
                for (int m = 0; m < 4; ++m)
#pragma unroll
                    for (int n = 0; n < 2; ++n) acc[a][b][m][n] = (f32x4){0.f, 0.f, 0.f, 0.f};
        cur = nxt; cA = nA; cB = nB; ++ui;
    }
    PG8_WAIT_V(0);
    if (wr == 0) PG8_BAR;
    PG8_BAR;
#undef PG8_STAGE_A
#undef PG8_EXPERT
#undef PG8_KT
#undef PG8_RSDMA
#undef PG8_SETV
#undef PG8_ABASE
#undef PG8_BBASE
#undef PG8_SA
#undef PG8_SB
#undef PG8_STAGE
#undef PG8_LDA
#undef PG8_LDB
#undef PG8_MMA
#undef PG8_CAT
#undef PG8_WAIT_V
#undef PG8_WAIT_L
#undef PG8_BAR
#undef PG8_SCHED
}
}

__device__ __forceinline__ void transpose_load(const float* W, int N, int item, int lane, float (&wv_)[32]) {
    const int nblk = N / 32, kb = item / nblk, nb = item % nblk, k0 = 64 * kb, n0 = 32 * nb;
#pragma unroll
    for (int i = 0; i < 8; ++i) { const int kk = 8 * i + (lane >> 3); const f32x4 v = __builtin_nontemporal_load((const f32x4*)(W + (size_t)(k0 + kk) * N + n0 + 4 * (lane & 7)));
        wv_[4 * i] = v[0]; wv_[4 * i + 1] = v[1]; wv_[4 * i + 2] = v[2]; wv_[4 * i + 3] = v[3]; }
}
template <int F8S = -1>
__device__ __forceinline__ void transpose_item(const float (&wv_)[32], int K, int N, bf16_t* WT, int mode, LAS float* scr, int item, int lane, const float* gain) {
    const int nblk = N / 32, kb = item / nblk, nb = item % nblk, k0 = 64 * kb, n0 = 32 * nb;
    const float gl = gain ? gain[k0 + lane] : 1.0f;
#pragma unroll
    for (int i = 0; i < 8; ++i) { const int kk = 8 * i + (lane >> 3); LAS float* d = scr + kk * 33 + 4 * (lane & 7);
        if (gain) { const float g = __int_as_float(__builtin_amdgcn_ds_bpermute(kk * 4, __float_as_int(gl))); d[0] = wv_[4 * i] * g; d[1] = wv_[4 * i + 1] * g; d[2] = wv_[4 * i + 2] * g; d[3] = wv_[4 * i + 3] * g; }
        else { d[0] = wv_[4 * i]; d[1] = wv_[4 * i + 1]; d[2] = wv_[4 * i + 2]; d[3] = wv_[4 * i + 3]; } }
    asm volatile("s_waitcnt lgkmcnt(0)" ::: "memory");
    int d0 = n0;
    if (mode == 1) { d0 = (n0 < DFF) ? ((n0 >> 7) * 256 + (n0 & 127)) : (((n0 - DFF) >> 7) * 256 + 128 + ((n0 - DFF) & 127)); }
    const int c = lane & 7;
#pragma unroll
    for (int j = 0; j < 4; ++j) { const int n = (lane >> 3) + 8 * j; const LAS float* s = scr + (8 * c) * 33 + n;
        if (F8S >= 0) { constexpr float sc = (float)(1 << (F8S < 0 ? 0 : F8S)); u32x2 o; o.x = cvt_pk4_fp8(s[0 * 33] * sc, s[1 * 33] * sc, s[2 * 33] * sc, s[3 * 33] * sc); o.y = cvt_pk4_fp8(s[4 * 33] * sc, s[5 * 33] * sc, s[6 * 33] * sc, s[7 * 33] * sc);
            *(u32x2*)((unsigned char*)WT + (size_t)(d0 + n) * K + k0 + 8 * c) = o; }
        else { u32x4 o; o.x = cvt_pk_bf16(s[0 * 33], s[1 * 33]); o.y = cvt_pk_bf16(s[2 * 33], s[3 * 33]); o.z = cvt_pk_bf16(s[4 * 33], s[5 * 33]); o.w = cvt_pk_bf16(s[6 * 33], s[7 * 33]);
            *(u32x4*)(WT + (size_t)(d0 + n) * K + k0 + 8 * c) = o; } }
    asm volatile("s_waitcnt lgkmcnt(0)" ::: "memory");
}

struct Params { const float* in[47]; float* out; unsigned char* ws; int lo, hi; };

__device__ __forceinline__ void prologue_phase(const Params& p, LAS unsigned char* lds, int G, int c, int wv) {
    const int tid = fresh_tid(wv), lane = tid & 63, wave = __builtin_amdgcn_readfirstlane(tid >> 6);
    LAS float* scr = (LAS float*)(lds + wave * 8448);
    bf16_t* WB = (bf16_t*)(p.ws + WS_WB);
    const int gw = c * 8 + wave, NGW = G * 8;
#define CVT_ONE(IN, KK, NN, MODE, NE, OFF, F8S, GIN) do { const int per = ((KK) / 64) * ((NN) / 32), tot = per * (NE); const float* src = p.in[IN]; bf16_t* dst = WB + (OFF); const float* gn = (GIN) >= 0 ? p.in[(GIN) < 0 ? 0 : (GIN)] : nullptr; \
        float ra[32]; if (gw < tot) { const int e = gw / per, r = gw - e * per; transpose_load(src + (size_t)e * (KK) * (NN), (NN), r, lane, ra); } \
        _Pragma("unroll 1") for (int it = gw; it < tot; it += NGW) { const int e = it / per, r = it - e * per; float rb[32]; const int nx = it + NGW; \
            if (nx < tot) { const int e2 = nx / per, r2 = nx - e2 * per; transpose_load(src + (size_t)e2 * (KK) * (NN), (NN), r2, lane, rb); }     \
            transpose_item<F8S>(ra, (KK), (NN), dst + (size_t)e * (KK) * (NN), (MODE), scr, r, lane, gn); \
            if (nx < tot) { _Pragma("unroll") for (int i_ = 0; i_ < 32; ++i_) ra[i_] = rb[i_]; } } } while (0)
#define SGU(L) (F8GU(L) ? F8S_WGU : -1)
#define SDN(L) (F8DN(L) ? F8S_WD : -1)
    CVT_ONE(2, 1024, 2048, 0, 1, O_L0_WIN, (((FP8_WIN) & 1) ? F8S_WGU : -1), 1); CVT_ONE(10, 1024, 1024, 0, 1, O_L0_WOUT, (((FP8_RES) & 1) ? F8S_WGU : -1), -1); CVT_ONE(12, 1024, 7168, 1, 1, O_L0_WGU, SGU(0), 11); CVT_ONE(13, 3584, 1024, 0, 1, O_L0_WD, SDN(0), -1);
    CVT_ONE(15, 1024, 1536, 0, 1, O_L1_QKV, (FP8_QKV1 ? F8S_WGU : -1), 14); CVT_ONE(18, 1024, 1024, 0, 1, O_L1_WOUT, (((FP8_RES) & 2) ? F8S_WGU : -1), -1); CVT_ONE(22, 1024, 7168, 1, 8, O_L1_WGU, SGU(1), 19); CVT_ONE(23, 3584, 1024, 0, 8, O_L1_WD, SDN(1), -1);
    CVT_ONE(25, 1024, 9216, 0, 1, O_L2_QKV, (FP8_QKV2 ? F8S_WGU : -1), 24); CVT_ONE(28, 1024, 1024, 0, 1, O_L2_WOUT, (((FP8_RES) & 4) ? F8S_WGU : -1), -1); CVT_ONE(30, 1024, 7168, 1, 1, O_L2_WGU, SGU(2), 29); CVT_ONE(31, 3584, 1024, 0, 1, O_L2_WD, SDN(2), -1);
    CVT_ONE(33, 1024, 2048, 0, 1, O_L3_WIN, (((FP8_WIN) & 8) ? F8S_WGU : -1), 32); CVT_ONE(41, 1024, 1024, 0, 1, O_L3_WOUT, (((FP8_RES) & 8) ? F8S_WGU : -1), -1); if (!LATE_CVT) CVT_ONE(45, 1024, 7168, 1, 8, O_L3_WGU, SGU(3), 42); CVT_ONE(46, 3584, 1024, 0, 8, O_L3_WD, SDN(3), -1);
#pragma unroll 1
    for (int L = 0; L < 2; ++L) {
        const float* wa = p.in[L ? 36 : 5]; const float* wx = p.in[L ? 38 : 7]; bf16_t* dst = WB + (L ? O_L3_GATE : O_L0_GATE);
        for (int i = c * 512 + tid; i < (int)E_GATE; i += G * 512) {
            const int cin = i & 127, dout = (i >> 7) & 127, n = (i >> 14) & 7, dir = (i >> 17) & 1, g = i >> 18;
            const float v = (g ? wx : wa)[((size_t)(dir * 8 + n) * 128 + cin) * 128 + dout];
            dst[i] = (bf16_t)(cvt_pk_bf16(-1.4426950408889634f * v, 0.f) & 0xffffu);
        }
    }
    { f32x2* T1 = (f32x2*)(p.ws + WS_T1); f32x2* T2 = (f32x2*)(p.ws + WS_T2);
      for (int i = c * 512 + tid; i < 128 * 32 + SEQ * 16; i += G * 512) { float sn, cs;
          if (i < 128 * 32) { const int pos = i >> 5, j = i & 31; sincosf((float)pos * exp2f(-(float)j * (13.287712379549449f / 32.0f)), &sn, &cs); T1[i] = (f32x2){cs, sn}; }
          else { const int k = i - 128 * 32, pos = k >> 4, j = k & 15; sincosf((float)pos * exp2f(-(float)j * (18.931568569324174f / 16.0f)), &sn, &cs); T2[k] = (f32x2){cs, sn}; } } }
    { bf16_t* XB = (bf16_t*)(p.ws + WS_XB); pg8::ss_t* SS = (pg8::ss_t*)(p.ws + WS_SS); const float* xin = p.in[0];
      for (int rb = gw * 4; rb < MT; rb += NGW * 4) {
          f32x4 xv[4][4];
#pragma unroll
          for (int r = 0; r < 4; ++r)
#pragma unroll
              for (int q = 0; q < 4; ++q) xv[r][q] = __builtin_nontemporal_load(((const f32x4*)(xin + (size_t)(rb + r) * DM) + lane) + 64 * q);
          asm volatile("" ::: "memory");
#pragma unroll
          for (int r = 0; r < 4; ++r) { const int row = rb + r; unsigned long long* o8 = (unsigned long long*)(XB + (size_t)row * DM) + lane; float sq = 0.f;
#pragma unroll
              for (int q = 0; q < 4; ++q) { const f32x4 v = xv[r][q]; sq += (v[0] * v[0] + v[1] * v[1]) + (v[2] * v[2] + v[3] * v[3]);
                  if ((FP8_WIN) & 1) { constexpr float sc = (float)(1 << F8S_HN); ((unsigned*)((unsigned char*)p.out + OUT_X8 + (size_t)row * DM) + lane)[64 * q] = cvt_pk4_fp8(v[0] * sc, v[1] * sc, v[2] * sc, v[3] * sc); }
                  o8[64 * q] = (unsigned long long)cvt_pk_bf16(v[0], v[1]) | ((unsigned long long)cvt_pk_bf16(v[2], v[3]) << 32); }
              sq = wave_sum(sq, lane); if (lane < 16) SS[(size_t)row * 16 + lane] = lane == 0 ? sq : 0.f; } } }
}
__device__ __forceinline__ void late_convert_l3gu(const Params& p, LAS unsigned char* lds, int ncw, int cw, int wv) {
    const int tid = fresh_tid(wv), lane = tid & 63, wave = __builtin_amdgcn_readfirstlane(tid >> 6);
    LAS float* scr = (LAS float*)(lds + wave * 8448);
    bf16_t* WB = (bf16_t*)(p.ws + WS_WB);
    const int gw = cw * 8 + wave, NGW = ncw * 8;
    CVT_ONE(45, 1024, 7168, 1, 8, O_L3_WGU, SGU(3), 42);
}
#undef CVT_ONE
#undef SGU
#undef SDN

template <bool ROUTE, int YMODE, bool F8OUT>
__device__ __forceinline__ void prep_phase(bf16_t* XB, const bf16_t* Y, const pg8::ss_t* ss_in, pg8::ss_t* ss_out, const float* gain, const float* router, const float* rbias, unsigned char* X8, float* outf,
                                           unsigned char* ws, LAS unsigned char* lds, int G, int c, int wv) {
    const int tid = fresh_tid(wv), lane = tid & 63, wave = __builtin_amdgcn_readfirstlane(tid >> 6);
    f32x4 gv[4];
#pragma unroll
    for (int q = 0; q < 4; ++q) gv[q] = ROUTE ? *(const f32x4*)(gain + 4 * lane + 256 * q) : (f32x4){0.f, 0.f, 0.f, 0.f};
    LAS float* RT = (LAS float*)lds;
    LAS int* e1 = (LAS int*)(lds + 32768);
    LAS int* wcnt = (LAS int*)(lds + 32768 + 2048);
    if (ROUTE) {
        for (int i = tid; i < 8192; i += 512) { const int k = i >> 3, e = i & 7; RT[e * 1024 + k] = router[i]; }
        __syncthreads();
    }
    int* TOPE = (int*)(ws + WS_TOPE); float* TOPG = (float*)(ws + WS_TOPG); int* LRANK = (int*)(ws + WS_LRANK); int* TCNT = (int*)(ws + WS_TCNT);
    float rb_[8];
#pragma unroll
    for (int e = 0; e < 8; ++e) rb_[e] = ROUTE ? rbias[e] : 0.f;
    for (int tile = c; tile < MT / 256; tile += G) {
#pragma unroll 1
        for (int i0 = 0; i0 < 32; i0 += 4) {
            u32x2 xv_[4][4], y0_[4][4], y1_[4][4]; float ssum_[4];
#pragma unroll
            for (int r = 0; r < 4; ++r) { const int row = tile * 256 + wave * 32 + i0 + r;
#pragma unroll
                for (int q = 0; q < 4; ++q) { xv_[r][q] = ((const u32x2*)(XB + (size_t)row * DM) + lane)[64 * q];
                    if (YMODE) { y0_[r][q] = *((const u32x2*)(Y + (size_t)row * DM) + lane + 64 * q); y1_[r][q] = *((const u32x2*)(Y + ((size_t)MT + row) * DM) + lane + 64 * q); } }
                ssum_[r] = ROUTE ? pg8::ss_row(ss_in, row) : 0.f; }
            asm volatile("" ::: "memory");
#pragma unroll
            for (int r = 0; r < 4; ++r) {
            const int i = i0 + r, row = tile * 256 + wave * 32 + i;
            f32x4 v[4]; float s = 0.f;
#pragma unroll
            for (int q = 0; q < 4; ++q) { const u32x2 xb = xv_[r][q];
                v[q][0] = __uint_as_float(xb.x << 16); v[q][1] = __uint_as_float(xb.x & 0xffff0000u); v[q][2] = __uint_as_float(xb.y << 16); v[q][3] = __uint_as_float(xb.y & 0xffff0000u);
                if (YMODE) { const u32x2 y0 = y0_[r][q], y1 = y1_[r][q];
                    v[q][0] += __uint_as_float(y0.x << 16) + __uint_as_float(y1.x << 16); v[q][1] += __uint_as_float(y0.x & 0xffff0000u) + __uint_as_float(y1.x & 0xffff0000u);
                    v[q][2] += __uint_as_float(y0.y << 16) + __uint_as_float(y1.y << 16); v[q][3] += __uint_as_float(y0.y & 0xffff0000u) + __uint_as_float(y1.y & 0xffff0000u); }
                if (YMODE == 1) { ((u32x2*)(XB + (size_t)row * DM) + lane)[64 * q] = (u32x2){cvt_pk_bf16(v[q][0], v[q][1]), cvt_pk_bf16(v[q][2], v[q][3])};
                    s += (v[q][0] * v[q][0] + v[q][1] * v[q][1]) + (v[q][2] * v[q][2] + v[q][3] * v[q][3]); }
                if (YMODE == 2) ((f32x4*)(outf + (size_t)row * DM) + lane)[64 * q] = v[q];
                if (F8OUT) { constexpr float sc = (float)(1 << F8S_HN); ((unsigned*)(X8 + (size_t)row * DM) + lane)[64 * q] = cvt_pk4_fp8(v[q][0] * sc, v[q][1] * sc, v[q][2] * sc, v[q][3] * sc); } }
            if (YMODE == 1) { s = wave_sum(s, lane); if (lane < 16) ss_out[(size_t)row * 16 + lane] = lane == 0 ? s : 0.f; }
            if (ROUTE) {
                const float rstd = 1.0f / sqrtf(ssum_[r] * (1.0f / DM) + EPS);
#pragma unroll
                for (int q = 0; q < 4; ++q) v[q] = v[q] * gv[q];
                float lg[8];
                { float pa[8];
#pragma unroll
                  for (int e = 0; e < 8; ++e) { float a = 0.f;
#pragma unroll
                    for (int q = 0; q < 4; ++q) { const f32x4 r4 = *(const LAS f32x4*)(RT + e * 1024 + 4 * lane + 256 * q); a += (v[q][0] * r4[0] + v[q][1] * r4[1]) + (v[q][2] * r4[2] + v[q][3] * r4[3]); }
                    pa[e] = a; }
                  const bool b5 = (lane & 32) != 0, b4 = (lane & 16) != 0, b3 = (lane & 8) != 0;
                  float pb[4], pc[2];
#pragma unroll
                  for (int i = 0; i < 4; ++i) { const float snd = b5 ? pa[i] : pa[i + 4], kp = b5 ? pa[i + 4] : pa[i]; pb[i] = kp + shfl_xor_l(snd, 32, lane); }
#pragma unroll
                  for (int i = 0; i < 2; ++i) { const float snd = b4 ? pb[i] : pb[i + 2], kp = b4 ? pb[i + 2] : pb[i]; pc[i] = kp + shfl_xor_l(snd, 16, lane); }
                  float pd = (b3 ? pc[1] : pc[0]) + shfl_xor_l(b3 ? pc[0] : pc[1], 8, lane);
                  pd += dpp_mov<0xB1>(pd); pd += dpp_mov<0x4E>(pd); pd += dpp_mov<0x141>(pd);
#pragma unroll
                  for (int e = 0; e < 8; ++e) lg[e] = __int_as_float(__builtin_amdgcn_readlane(__float_as_int(pd), 32 * (e >> 2) + 16 * ((e >> 1) & 1) + 8 * (e & 1))) * rstd + rb_[e]; }
                float b1 = lg[0], b2 = -3.0e38f; int i1 = 0, i2 = 0;
#pragma unroll
                for (int e = 1; e < 8; ++e) { if (lg[e] > b1) { b2 = b1; i2 = i1; b1 = lg[e]; i1 = e; } else if (lg[e] > b2) { b2 = lg[e]; i2 = e; } }
                const float g1 = 1.0f / (1.0f + __expf(b2 - b1));
                if (lane == 0) { e1[wave * 32 + i] = i1; e1[256 + wave * 32 + i] = i2; TOPE[(size_t)row * 2] = i1; TOPE[(size_t)row * 2 + 1] = i2; TOPG[(size_t)row * 2] = g1; TOPG[(size_t)row * 2 + 1] = 1.0f - g1; }
            }
            }
        }
        if (ROUTE) {
            __syncthreads();
            const int k = tid >> 8, tl = tid & 255, e = e1[k * 256 + tl]; int rank = 0;
#pragma unroll
            for (int ee = 0; ee < 8; ++ee) { const unsigned long long mk = __ballot(e == ee); if (e == ee) rank = __popcll(mk & ((1ull << lane) - 1ull)); if (lane == 0) wcnt[wave * 8 + ee] = __popcll(mk); }
            __syncthreads();
            int base = 0; const int w0 = k * 4;
            for (int w2 = w0; w2 < wave; ++w2) base += wcnt[w2 * 8 + e];
            LRANK[(size_t)(tile * 256 + tl) * 2 + k] = base + rank;
            if (tid < 16) { const int kk = tid >> 3, ee = tid & 7; TCNT[tile * 16 + tid] = wcnt[(kk * 4 + 0) * 8 + ee] + wcnt[(kk * 4 + 1) * 8 + ee] + wcnt[(kk * 4 + 2) * 8 + ee] + wcnt[(kk * 4 + 3) * 8 + ee]; }
            __syncthreads();
        }
    }
}

__device__ __forceinline__ void moe_scatter_phase(unsigned char* ws, const pg8::ss_t* ss, LAS unsigned char* lds, int G, int c, int wv) {
    const int tid = fresh_tid(wv);
    LAS int* tot = (LAS int*)lds; LAS int* off = tot + 16; LAS int* pre = tot + 32;
    const int* TCNT = (const int*)(ws + WS_TCNT); int* META = (int*)(ws + WS_META);
    const int* TOPE = (const int*)(ws + WS_TOPE); const float* TOPG = (const float*)(ws + WS_TOPG); const int* LRANK = (const int*)(ws + WS_LRANK);
    int* SIDX = (int*)(ws + WS_SIDX); float* SGATE = (float*)(ws + WS_SGATE); float* SRS = (float*)(ws + WS_SRS);
    for (int tile = c; tile < MT / 256; tile += G) {
        { LAS int* cnt = tot + 64; LAS int* seg = cnt + 4096;
          for (int i = tid; i < 4096; i += 512) cnt[i] = TCNT[i];
          __syncthreads();
          if (tid < 128) { const int e = tid & 7, sg = tid >> 3; int t = 0, pr = 0;
#pragma unroll
              for (int j = 0; j < 16; ++j) { const int w = sg * 16 + j; const int v = cnt[w * 16 + e] + cnt[w * 16 + 8 + e]; t += v; pr += (w < tile) ? v : 0; }
              seg[sg * 16 + e] = t; seg[sg * 16 + 8 + e] = pr; }
          __syncthreads();
          if (tid < 8) { int t = 0, pr = 0;
#pragma unroll
              for (int sg = 0; sg < 16; ++sg) { t += seg[sg * 16 + tid]; pr += seg[sg * 16 + 8 + tid]; }
              tot[tid] = t; pre[tid] = pr; pre[8 + tid] = pr + cnt[tile * 16 + tid]; } }
        __syncthreads();
        if (tid == 0) { int o = 0; for (int j = 0; j < 8; ++j) { off[j] = o; o += (tot[j] + 255) & ~255; } off[8] = o; }
        __syncthreads();
        if (tile == 0) {
            if (tid < 9) META[tid] = off[tid];
            if (tid < 8) META[16 + tid] = tot[tid];
            if (tid == 0) META[33] = off[8] >> 8;
            for (int j = 0; j < 8; ++j) { const int t0 = off[j] >> 8, t1 = off[j + 1] >> 8; for (int t = t0 + tid; t < t1; t += 512) META[64 + t] = j;
                for (int r = off[j] + tot[j] + tid; r < off[j + 1]; r += 512) { SIDX[r] = -1; SGATE[r] = 0.f; SRS[r] = 0.f; } }
        }
        const int k = tid >> 8, tl = tid & 255, tok = tile * 256 + tl, e = TOPE[(size_t)tok * 2 + k];
        const int pos = off[e] + pre[k * 8 + e] + LRANK[(size_t)tok * 2 + k];
        SIDX[pos] = tok | (k << 20); SGATE[pos] = TOPG[(size_t)tok * 2 + k]; SRS[pos] = pg8::rstd_of(ss, tok);
        __syncthreads();
    }
}

constexpr int XC_STRIDE = 272;
constexpr int XT_STRIDE = 68;
constexpr int HS_STRIDE = 132;
constexpr int RG_XT = 64 * XC_STRIDE, RG_HSF = RG_XT + 128 * XT_STRIDE * 4, RG_HSB = RG_HSF + 64 * HS_STRIDE * 4, RG_CW = RG_HSB + 64 * HS_STRIDE * 4;
static_assert(RG_CW + 2560 <= 131072, "RG LDS");
template <int MODE, int DIR>
__device__ __forceinline__ void rg_unit(const LAS unsigned char* XC, const LAS float* XT, LAS float* HSm, const bf16x8 (&wf)[2][8], float ba, float bx, float cc, float& cy, float& pp, int cs, int r32, int hi) {
#pragma unroll
    for (int mi = 0; mi < 2; ++mi) { const int mt = DIR ? 1 - mi : mi;
        f32x16 aa, ax;
#pragma unroll
        for (int r = 0; r < 16; ++r) { aa[r] = ba; ax[r] = bx; }
#pragma unroll
        for (int ks = 0; ks < 8; ++ks) { const bf16x8 xf = *(const LAS bf16x8*)(XC + (32 * mt + r32) * XC_STRIDE + (16 * ks + 8 * hi) * 2);
            aa = __builtin_amdgcn_mfma_f32_32x32x16_bf16(xf, wf[0][ks], aa, 0, 0, 0);
            ax = __builtin_amdgcn_mfma_f32_32x32x16_bf16(xf, wf[1][ks], ax, 0, 0, 0); }
#pragma unroll
        for (int q4 = 0; q4 < 4; ++q4) { const f32x4 xv = *(const LAS f32x4*)(XT + (32 * cs + r32) * XT_STRIDE + 32 * mt + 8 * q4 + 4 * hi);
#pragma unroll
            for (int j = 0; j < 4; ++j) { const int r = 4 * q4 + j;
                const float rg = __builtin_amdgcn_rcpf(1.0f + __builtin_amdgcn_exp2f(aa[r])), ig = __builtin_amdgcn_rcpf(1.0f + __builtin_amdgcn_exp2f(ax[r]));
                const float A = __builtin_amdgcn_exp2f(cc * rg);
                aa[r] = A; ax[r] = __builtin_amdgcn_sqrtf(fmaf(-A, A, 1.0f)) * ig * xv[j]; }
            if (DIR == 0) {
#pragma unroll
                for (int j = 1; j < 4; ++j) { const int r = 4 * q4 + j; ax[r] = fmaf(aa[r], ax[r - 1], ax[r]); aa[r] *= aa[r - 1]; }
            } else {
#pragma unroll
                for (int j = 2; j >= 0; --j) { const int r = 4 * q4 + j; ax[r] = fmaf(aa[r], ax[r + 1], ax[r]); aa[r] *= aa[r + 1]; }
            }
            __builtin_amdgcn_sched_barrier(0); }
#pragma unroll
        for (int qi = 0; qi < 4; ++qi) { const int q4 = DIR ? 3 - qi : qi, rt = 4 * q4 + (DIR ? 0 : 3);
            const float th = ax[rt], tp = aa[rt];
            const float t1 = fmaf(tp, cy, th);
            float c1;
            if (DIR == 0) { auto s1 = __builtin_amdgcn_permlane32_swap(__float_as_uint(cy), __float_as_uint(t1), false, false); c1 = __uint_as_float(s1[0]); }
            else          { auto s1 = __builtin_amdgcn_permlane32_swap(__float_as_uint(t1), __float_as_uint(cy), false, false); c1 = __uint_as_float(s1[1]); }
            const float t2 = fmaf(tp, c1, th);
            { auto s2 = __builtin_amdgcn_permlane32_swap(__float_as_uint(t2), __float_as_uint(t2), false, false); cy = __uint_as_float(DIR ? s2[0] : s2[1]); }
            if (MODE == 0) pp *= tp;
            if (MODE == 1) {
#pragma unroll
                for (int j = 0; j < 4; ++j) { const int r = 4 * q4 + j; HSm[(32 * mt + 8 * q4 + 4 * hi + j) * HS_STRIDE + 32 * cs + r32] = fmaf(aa[r], c1, ax[r]); } }
        }
    }
}
template <int MODE>
__device__ __forceinline__ void rg_phase(const bf16_t* XBR, const bf16_t* GY, bf16_t* RGO, unsigned char* RGO8, const bf16_t* GW, const float* conv_w, const float* conv_b,
                                         const float* b_a, const float* b_x, const float* lam, float* SUMP, float* SUMH, const float* CARRY, LAS unsigned char* lds, int G, int c, int wv) {
    const int tid0 = fresh_tid(wv), lane0 = tid0 & 63, wave = __builtin_amdgcn_readfirstlane(tid0 >> 6);
    const int dir = wave >> 2, cs = wave & 3;
    constexpr float L2E = 1.4426950408889634f;
    LAS unsigned char* XC = lds;
    LAS float* XT = (LAS float*)(lds + RG_XT);
    LAS float* HSm = (LAS float*)(lds + (dir ? RG_HSB : RG_HSF));
    LAS float* CW = (LAS float*)(lds + RG_CW);
    const bool g8 = (G % 8) == 0;
    for (int n = g8 ? c % 8 : 0; n < 8; n += g8 ? 8 : 1) {
        const int jw = g8 ? c / 8 : c, nj = g8 ? G / 8 : G;
        __syncthreads();
        for (int i = tid0; i < 640; i += 512) CW[i] = (i < 512) ? conv_w[(i >> 7) * 1024 + n * 128 + (i & 127)] : conv_b[n * 128 + (i - 512)];
        const char* wb0 = (const char*)(GW + ((size_t)(dir * 8 + n) * 128 + 32 * cs) * 128);
        const char* wb1 = wb0 + (size_t)(2 * 8 * 128 * 128) * 2;
        bf16x8 wf[2][8];
        float ba, bx, cc;
        { const int r32 = lane0 & 31, hi = lane0 >> 5; const unsigned woff0 = (unsigned)(r32 * 128 + 8 * hi) * 2u;
#pragma unroll
          for (int g = 0; g < 2; ++g)
#pragma unroll
              for (int ks = 0; ks < 8; ++ks) wf[g][ks] = *(const bf16x8*)((g ? wb1 : wb0) + (woff0 + (unsigned)(ks * 32)));
          const int chg = dir * 1024 + n * 128 + 32 * cs + r32;
          ba = -L2E * b_a[chg]; bx = -L2E * b_x[chg]; cc = -8.0f * L2E * log1pf(__expf(-lam[chg])); }
        __syncthreads();
        bf16x8 xr[2][4];
#define RG_XLOAD(Q) do { const int _b = (Q) / RG_NCH, _t0 = ((Q) % RG_NCH) * RG_L; int _ln = lane0; asm volatile("" : "+v"(_ln)); \
            _Pragma("unroll") for (int it = 0; it < 2; ++it) _Pragma("unroll") for (int jt = 0; jt < 4; ++jt) { int pos = _t0 + _ln + jt - 2; pos = pos < 0 ? 0 : (pos >= SEQ ? SEQ - 1 : pos);     \
                const char* xb = (const char*)(XBR + (size_t)_b * SEQ * DM + n * 128 + 8 * (wave + 8 * it)); \
                xr[it][jt] = *(const bf16x8*)(xb + (unsigned)pos * (unsigned)(DM * 2)); } } while (0)
        if (jw < NBATCH * RG_NCH) RG_XLOAD(jw);
        bool pend = false; float pend_p = 0.f, pend_h = 0.f; u32x4 pend_o[2] = {}; size_t pend_base = 0;
#define RG_FLUSH() do { if (pend) { if (MODE == 0) { if ((lane0 >> 5) == 0) { SUMP[pend_base + (lane0 & 31)] = pend_p; SUMH[pend_base + (lane0 & 31)] = pend_h; } } \
            else { _Pragma("unroll") for (int it = 0; it < 2; ++it) { const int item = tid0 + 512 * it, tl = item >> 4, c8 = item & 15; \
                if (RGO8) *(u32x2*)(RGO8 + pend_base / 2 + (unsigned)(tl * DM + 8 * c8)) = (u32x2){pend_o[it].x, pend_o[it].y}; else *(u32x4*)((char*)RGO + pend_base + (unsigned)(tl * DM + 8 * c8) * 2u) = pend_o[it]; } } } } while (0)
        for (int q = jw; q < NBATCH * RG_NCH; q += nj) {
            const int b = q / RG_NCH, ch = q % RG_NCH, t0 = ch * RG_L; const size_t row0 = (size_t)b * SEQ + t0;
            int lane_l = lane0; asm volatile("" : "+v"(lane_l));
            const int lane = lane_l, r32 = lane & 31, hi = lane >> 5, tid = (wave << 6) | lane;
            bf16x8 gyv[2];
            float cy = 0.f, pp = 1.f;
            if (MODE == 1) { cy = CARRY[((size_t)(b * RG_NCH + ch) * 2 + dir) * 1024 + n * 128 + 32 * cs + r32];
#pragma unroll
                for (int it = 0; it < 2; ++it) { const int item = tid + 512 * it, tl = item >> 4, c8 = item & 15;
                    gyv[it] = *(const bf16x8*)((const char*)GY + (row0 * DM + n * 128) * 2 + (unsigned)(tl * DM + 8 * c8) * 2u); } }
#pragma unroll
            for (int it = 0; it < 2; ++it) { const int c8 = wave + 8 * it, tl = lane;
                float xc[8];
                { const f32x4 b0 = *(const LAS f32x4*)(CW + 512 + 8 * c8), b1 = *(const LAS f32x4*)(CW + 512 + 8 * c8 + 4);
#pragma unroll
                  for (int j = 0; j < 4; ++j) { xc[j] = b0[j]; xc[4 + j] = b1[j]; } }
#pragma unroll
                for (int jt = 0; jt < 4; ++jt) { const int pos = t0 + tl + jt - 2; const bf16x8 xv = (pos >= 0 && pos < SEQ) ? xr[it][jt] : (bf16x8){0, 0, 0, 0, 0, 0, 0, 0};
                        const f32x4 w0 = *(const LAS f32x4*)(CW + jt * 128 + 8 * c8), w1 = *(const LAS f32x4*)(CW + jt * 128 + 8 * c8 + 4);
#pragma unroll
                        for (int j = 0; j < 4; ++j) { xc[j] += bf2f(xv[j]) * w0[j]; xc[4 + j] += bf2f(xv[4 + j]) * w1[j]; } }
                u32x4 o; o.x = cvt_pk_bf16(xc[0], xc[1]); o.y = cvt_pk_bf16(xc[2], xc[3]); o.z = cvt_pk_bf16(xc[4], xc[5]); o.w = cvt_pk_bf16(xc[6], xc[7]);
                *(LAS u32x4*)(XC + tl * XC_STRIDE + c8 * 16) = o;
#pragma unroll
                for (int j = 0; j < 8; ++j) XT[(8 * c8 + j) * XT_STRIDE + tl] = xc[j]; }
            RG_FLUSH();
            __syncthreads();
            if (MODE == 1) asm volatile("" : "+v"(cy));
            if (q + nj < NBATCH * RG_NCH) RG_XLOAD(q + nj);
            if (dir == 0) rg_unit<MODE, 0>(XC, XT, HSm, wf, ba, bx, cc, cy, pp, cs, r32, hi);
            else          rg_unit<MODE, 1>(XC, XT, HSm, wf, ba, bx, cc, cy, pp, cs, r32, hi);
            if (MODE == 0) {
                { auto s3 = __builtin_amdgcn_permlane32_swap(__float_as_uint(pp), __float_as_uint(pp), false, false); pp = __uint_as_float(s3[0]) * __uint_as_float(s3[1]); }
                pend_base = ((size_t)(b * RG_NCH + ch) * 2 + dir) * 1024 + n * 128 + 32 * cs; pend_p = pp; pend_h = cy; pend = true;
                __syncthreads();
            } else {
                __syncthreads();
                const LAS float* HF = (const LAS float*)(lds + RG_HSF); const LAS float* HB = (const LAS float*)(lds + RG_HSB);
#pragma unroll
                for (int it = 0; it < 2; ++it) { const int item = tid + 512 * it, tl = item >> 4, c8 = item & 15;
                    const f32x4 h0 = *(const LAS f32x4*)(HF + tl * HS_STRIDE + 8 * c8) + *(const LAS f32x4*)(HB + tl * HS_STRIDE + 8 * c8);
                    const f32x4 h1 = *(const LAS f32x4*)(HF + tl * HS_STRIDE + 8 * c8 + 4) + *(const LAS f32x4*)(HB + tl * HS_STRIDE + 8 * c8 + 4);
                    const size_t gob = (row0 * DM + n * 128) * 2; const unsigned gof = (unsigned)(tl * DM + 8 * c8) * 2u;
                    const bf16x8 gy = gyv[it];
                    u32x4 o;
                    if (RGO8) { constexpr float sc = (float)(1 << F8S_AO); o.x = cvt_pk4_fp8(bf2f(gy[0]) * h0[0] * sc, bf2f(gy[1]) * h0[1] * sc, bf2f(gy[2]) * h0[2] * sc, bf2f(gy[3]) * h0[3] * sc);
                        o.y = cvt_pk4_fp8(bf2f(gy[4]) * h1[0] * sc, bf2f(gy[5]) * h1[1] * sc, bf2f(gy[6]) * h1[2] * sc, bf2f(gy[7]) * h1[3] * sc); o.z = 0u; o.w = 0u; }
                    else { o.x = cvt_pk_bf16(bf2f(gy[0]) * h0[0], bf2f(gy[1]) * h0[1]); o.y = cvt_pk_bf16(bf2f(gy[2]) * h0[2], bf2f(gy[3]) * h0[3]);
                    o.z = cvt_pk_bf16(bf2f(gy[4]) * h1[0], bf2f(gy[5]) * h1[1]); o.w = cvt_pk_bf16(bf2f(gy[6]) * h1[2], bf2f(gy[7]) * h1[3]); }
                    (void)gof; pend_o[it] = o; pend_base = gob; }
                pend = true;
            }
        }
        RG_FLUSH();
    }
}
#undef RG_FLUSH
#undef RG_XLOAD
__device__ __forceinline__ void rg_carry_phase(const float* SUMP, const float* SUMH, float* CARRY, LAS unsigned char* lds, int G, int c, int wv) {
    static_assert(RG_NCH == 128, "8 waves x 16 chunks");
    const int tid = fresh_tid(wv), lane = tid & 63, wave = __builtin_amdgcn_readfirstlane(tid >> 6);
    LAS float* XP = (LAS float*)lds; LAS float* XH = XP + 512;
    for (int s0 = c * 64; s0 < NBATCH * 2 * 1024; s0 += G * 64) {
        const int s = s0 + lane, chn = s & 1023, dir = (s >> 10) & 1, b = s >> 11;
        float pv[16], hv[16];
#pragma unroll
        for (int j = 0; j < 16; ++j) { const int i = 16 * wave + j, ch = dir ? RG_NCH - 1 - i : i; const size_t o = ((size_t)(b * RG_NCH + ch) * 2 + dir) * 1024 + chn; pv[j] = SUMP[o]; hv[j] = SUMH[o]; }
        float P = 1.f, H = 0.f;
#pragma unroll
        for (int j = 0; j < 16; ++j) { H = H * pv[j] + hv[j]; P *= pv[j]; }
        XP[wave * 64 + lane] = P; XH[wave * 64 + lane] = H;
        __syncthreads();
        float cy = 0.f;
        for (int w = 0; w < wave; ++w) cy = cy * XP[w * 64 + lane] + XH[w * 64 + lane];
#pragma unroll
        for (int j = 0; j < 16; ++j) { const int i = 16 * wave + j, ch = dir ? RG_NCH - 1 - i : i; const size_t o = ((size_t)(b * RG_NCH + ch) * 2 + dir) * 1024 + chn; CARRY[o] = cy; cy = cy * pv[j] + hv[j]; }
        __syncthreads();
    }
}

template <bool AXIAL>
__device__ __forceinline__ void qknorm_rope_phase(bf16_t* QKV, int nrows, int ld, int vec0, int nvec, const float* qg, const float* kg, int G, int c, int wv, unsigned char* k8 = nullptr) {
    const int tid = fresh_tid(wv), lane = tid & 63, wave = __builtin_amdgcn_readfirstlane(tid >> 6), i16 = lane & 15, grp = lane >> 4;
    float gq[8], gk[8];
#pragma unroll
    for (int k = 0; k < 8; ++k) { gq[k] = qg[8 * i16 + k]; gk[k] = kg[8 * i16 + k]; }
    float fj[8];
#pragma unroll
    for (int k = 0; k < 8; ++k) { if (AXIAL) fj[k] = exp2f(-(float)(8 * (i16 & 3) + k) * (13.287712379549449f / 32.0f)); else fj[k] = exp2f(-(float)(8 * (i16 & 1) + k) * (18.931568569324174f / 16.0f)); }
    const bool rot = AXIAL ? true : (i16 < 4);
    const bool second = AXIAL ? ((i16 >> 2) & 1) : ((i16 >> 1) & 1);
    for (int row = c * 8 + wave; row < nrows; row += G * 8) {
        const int t = row % SEQ;
        const float pos = AXIAL ? (float)((i16 < 8) ? (t >> 6) : (t & 63)) : (float)t;
        float cs_[8], sn_[8];
#pragma unroll
        for (int k = 0; k < 8; ++k) { float s, cc; sincosf(pos * fj[k], &s, &cc); cs_[k] = cc; sn_[k] = s; }
#pragma unroll 1
        for (int v0 = vec0; v0 < nvec; v0 += 4) {
            const int vec = v0 + grp; const bool act = vec < nvec; const int vv = act ? vec : 0;
            int col; bool isq;
            if (AXIAL) { isq = vv < 8; col = isq ? vv * 128 : 1024 + (vv - 8) * 128; }
            else { const int g = vv >> 4, qk = (vv >> 3) & 1, h = vv & 7; isq = qk == 0; col = g * 3072 + qk * 1024 + h * 128; }
            bf16_t* ptr = QKV + (size_t)row * ld + col + 8 * i16;
            const bf16x8 xv = *(const bf16x8*)ptr;
            float y[8]; float ss = 0.f;
#pragma unroll
            for (int k = 0; k < 8; ++k) { y[k] = bf2f(xv[k]); ss += y[k] * y[k]; }
            ss = row16_sum(ss);
            const float rstd = 1.0f / sqrtf(ss * (1.0f / 128.0f) + EPS);
#pragma unroll
            for (int k = 0; k < 8; ++k) y[k] = y[k] * rstd * (isq ? gq[k] : gk[k]);
            float o[8];
#pragma unroll
            for (int k = 0; k < 8; ++k) { const float py = shfl_xor_l(y[k], AXIAL ? 4 : 2, lane);
                o[k] = rot ? (second ? (y[k] * cs_[k] + py * sn_[k]) : (y[k] * cs_[k] - py * sn_[k])) : y[k]; }
            u32x4 w; w.x = cvt_pk_bf16(o[0], o[1]); w.y = cvt_pk_bf16(o[2], o[3]); w.z = cvt_pk_bf16(o[4], o[5]); w.w = cvt_pk_bf16(o[6], o[7]);
            if (AXIAL && k8) { if (act) { const int kvh = vv - 8, b = row / SEQ; u32x2 q8; q8.x = cvt_pk4_fp8(o[0] * 4.f, o[1] * 4.f, o[2] * 4.f, o[3] * 4.f); q8.y = cvt_pk4_fp8(o[4] * 4.f, o[5] * 4.f, o[6] * 4.f, o[7] * 4.f);
                    *(u32x2*)(k8 + ((size_t)(b * 2 + kvh) * SEQ + t) * 128 + 64 * (i16 >> 3) + 32 * (i16 & 1) + 8 * ((i16 >> 1) & 3)) = q8; } }
            else if (act) *(u32x4*)ptr = w;
        }
    }
}

constexpr float ATT_SCALE = 0.088388347648318440f;
constexpr float ATT_THR = 8.f;
#define KSWZ(row, colB) ((row) * 256 + ((colB) ^ (((row) & 7) << 4)))
#define SBAR() __builtin_amdgcn_sched_barrier(0)
__device__ __forceinline__ int crow(int r, int hi) { return (r & 3) + 8 * (r >> 2) + 4 * hi; }
__device__ __forceinline__ void partialSM(f32x16& p0, f32x16& p1, float& m_reg, float& mn, float& alpha) {
    constexpr float C = ATT_SCALE * 1.4426950408889634f;
    float pmax = p0[0];
#pragma unroll
    for (int r = 1; r < 16; ++r) pmax = fmaxf(pmax, p0[r]);
#pragma unroll
    for (int r = 0; r < 16; ++r) pmax = fmaxf(pmax, p1[r]);
    { auto rr = __builtin_amdgcn_permlane32_swap(__float_as_uint(pmax), __float_as_uint(pmax), false, false);
      pmax = fmaxf(__uint_as_float(rr[0]), __uint_as_float(rr[1])); }
    if (__builtin_expect(__all(pmax - m_reg <= ATT_THR / ATT_SCALE), 1)) { mn = m_reg; alpha = 1.f; }
    else { mn = fmaxf(m_reg, pmax); alpha = __builtin_amdgcn_exp2f((m_reg - mn) * C); m_reg = mn; }
    float mnC = -mn * C;
#pragma unroll
    for (int r = 0; r < 16; ++r) p0[r] = fmaf(p0[r], C, mnC);
#pragma unroll
    for (int r = 0; r < 16; ++r) p1[r] = fmaf(p1[r], C, mnC);
#pragma unroll
    for (int r = 0; r < 16; ++r) p0[r] = __builtin_amdgcn_exp2f(p0[r]);
}
#define PK4(P, BASE, OUT) do { unsigned a0 = cvt_pk_bf16(P[BASE + 0], P[BASE + 1]), a1 = cvt_pk_bf16(P[BASE + 2], P[BASE + 3]);   \
    unsigned b0 = cvt_pk_bf16(P[BASE + 4], P[BASE + 5]), b1 = cvt_pk_bf16(P[BASE + 6], P[BASE + 7]);                              \
    auto r0 = __builtin_amdgcn_permlane32_swap(a0, b0, false, false); auto r1 = __builtin_amdgcn_permlane32_swap(a1, b1, false, false); \
    u32x4 w = {r0[0], r1[0], r0[1], r1[1]}; OUT = *reinterpret_cast<bf16x8*>(&w); } while (0)
__device__ __forceinline__ void finishSM(f32x16& p0, f32x16& p1, float alpha, float& l_reg, bf16x8& pa0, bf16x8& pa1, bf16x8& pa2, bf16x8& pa3) {
#pragma unroll
    for (int r = 0; r < 16; ++r) p1[r] = __builtin_amdgcn_exp2f(p1[r]);
    float ps = 0;
#pragma unroll
    for (int r = 0; r < 16; ++r) ps += p0[r];
#pragma unroll
    for (int r = 0; r < 16; ++r) ps += p1[r];
    { auto rr = __builtin_amdgcn_permlane32_swap(__float_as_uint(ps), __float_as_uint(ps), false, false);
      ps = __uint_as_float(rr[0]) + __uint_as_float(rr[1]); }
    l_reg = l_reg * alpha + ps;
    PK4(p0, 0, pa0); PK4(p0, 8, pa1); PK4(p1, 0, pa2); PK4(p1, 8, pa3);
}
__device__ __forceinline__ void qkt(f32x16& p0, f32x16& p1, const char* Ks, const bf16x8* qr, int r32, int hi) {
    p0 = f32x16{}; p1 = f32x16{};
#pragma unroll
    for (int d0 = 0; d0 < 8; ++d0) { int cb = (d0 * 16 + hi * 8) * 2;
        bf16x8 b0 = *reinterpret_cast<const bf16x8*>(Ks + KSWZ(r32, cb));
        bf16x8 b1 = *reinterpret_cast<const bf16x8*>(Ks + KSWZ(32 + r32, cb));
        p0 = __builtin_amdgcn_mfma_f32_32x32x16_bf16(b0, qr[d0], p0, 0, 0, 0);
        p1 = __builtin_amdgcn_mfma_f32_32x32x16_bf16(b1, qr[d0], p1, 0, 0, 0); }
}
__device__ __forceinline__ int v_st(int k, int c) { const int kk = (k & ~0xC) | ((k & 4) << 1) | ((k & 8) >> 1); return ((kk >> 3) * 4 + (c >> 5)) * 512 + ((kk & 7) * 32 + (c & 31)) * 2; }
__device__ __forceinline__ int v_rd_base(int lane) { return ((lane & 3) << 3) | (((lane >> 2) & 3) << 6) | (((lane >> 4) & 1) << 5) | (((lane >> 5) & 1) << 8); }
constexpr int v_rd_off(int d0, int ks, int half) { return d0 * 512 + ks * 4096 + half * 2048; }
template <int OFF> __device__ __forceinline__ s16x4 tr_read(int vb) {
    s16x4 r; asm volatile("ds_read_b64_tr_b16 %0, %1 offset:%2" : "=&v"(r) : "v"(vb), "i"(OFF) : "memory"); return r;
}
#define PKV(L, H) (bf16x8){L[0], L[1], L[2], L[3], H[0], H[1], H[2], H[3]}
template <int D0> __device__ __forceinline__ void pv_one(f32x16& od, int vb, bf16x8 pa0, bf16x8 pa1, bf16x8 pa2, bf16x8 pa3) {
    const s16x4 l0 = tr_read<v_rd_off(D0, 0, 0)>(vb), h0 = tr_read<v_rd_off(D0, 0, 1)>(vb), l1 = tr_read<v_rd_off(D0, 1, 0)>(vb), h1 = tr_read<v_rd_off(D0, 1, 1)>(vb);
    const s16x4 l2 = tr_read<v_rd_off(D0, 2, 0)>(vb), h2 = tr_read<v_rd_off(D0, 2, 1)>(vb), l3 = tr_read<v_rd_off(D0, 3, 0)>(vb), h3 = tr_read<v_rd_off(D0, 3, 1)>(vb);
    asm volatile("s_waitcnt lgkmcnt(0)" ::: "memory"); SBAR();
    od = __builtin_amdgcn_mfma_f32_32x32x16_bf16(pa0, PKV(l0, h0), od, 0, 0, 0);
    od = __builtin_amdgcn_mfma_f32_32x32x16_bf16(pa1, PKV(l1, h1), od, 0, 0, 0);
    od = __builtin_amdgcn_mfma_f32_32x32x16_bf16(pa2, PKV(l2, h2), od, 0, 0, 0);
    od = __builtin_amdgcn_mfma_f32_32x32x16_bf16(pa3, PKV(l3, h3), od, 0, 0, 0);
}
__device__ __forceinline__ void pv_d0(f32x16* o, int vb, bf16x8 pa0, bf16x8 pa1, bf16x8 pa2, bf16x8 pa3) {
    pv_one<0>(o[0], vb, pa0, pa1, pa2, pa3); pv_one<1>(o[1], vb, pa0, pa1, pa2, pa3); pv_one<2>(o[2], vb, pa0, pa1, pa2, pa3); pv_one<3>(o[3], vb, pa0, pa1, pa2, pa3);
}

constexpr int SHM_V = 64 * 128 * 2, SHM_K = 64 * 128 * 2;
template <int LDQ, int LDK, int LDO, bool QFUSE>
__device__ __forceinline__ void attn_dense_body(const bf16_t* __restrict__ Qb, const bf16_t* __restrict__ Kh, const bf16_t* __restrict__ Vh, bf16_t* __restrict__ Ob, int seq, char* lds, int wv,
                                                const float* qg = nullptr, const f32x2* T1 = nullptr, int tq0 = 0) {
    const int tid = fresh_tid(wv), wid = tid >> 6, lane = tid & 63, r32 = lane & 31, hi = lane >> 5;
    char* V_lds = lds; char* K_lds = lds + 2 * SHM_V;
    float* wsp = (float*)(lds + 2 * SHM_V + 2 * SHM_K) + wid * 64; float* li_l = wsp; float* al_l = wsp + 32;
    float m_reg = -1e30f, l_reg = 0; f32x16 o[4] = {}; bf16x8 qr[8];
    const bf16_t* Qw = Qb + (long)(wid * 32 + r32) * LDQ + hi * 8;
#pragma unroll
    for (int d0 = 0; d0 < 8; ++d0) qr[d0] = *(const bf16x8*)(Qw + d0 * 16);
    if (QFUSE) {
        float ss = 0.f;
#pragma unroll
        for (int d0 = 0; d0 < 8; ++d0)
#pragma unroll
            for (int j = 0; j < 8; ++j) { const float x = bf2f(qr[d0][j]); ss += x * x; }
        { auto rr = __builtin_amdgcn_permlane32_swap(__float_as_uint(ss), __float_as_uint(ss), false, false); ss = __uint_as_float(rr[0]) + __uint_as_float(rr[1]); }
        const float rstd = 1.0f / sqrtf(ss * (1.0f / 128.0f) + EPS);
        const int t = tq0 + wid * 32 + r32;
#pragma unroll
        for (int hf = 0; hf < 2; ++hf) { const int pos = hf ? (t & 63) : (t >> 6);
#pragma unroll
            for (int a = 0; a < 2; ++a) { const int d1 = 4 * hf + a, d2 = d1 + 2;
                const f32x4* tp = (const f32x4*)(T1 + pos * 32 + 16 * a + 8 * hi); const f32x4 c01 = tp[0], c23 = tp[1], c45 = tp[2], c67 = tp[3];
                const float cs_[8] = {c01[0], c01[2], c23[0], c23[2], c45[0], c45[2], c67[0], c67[2]}, sn_[8] = {c01[1], c01[3], c23[1], c23[3], c45[1], c45[3], c67[1], c67[3]};
                const f32x4 g1a = *(const f32x4*)(qg + 16 * d1 + 8 * hi), g1b = *(const f32x4*)(qg + 16 * d1 + 8 * hi + 4), g2a = *(const f32x4*)(qg + 16 * d2 + 8 * hi), g2b = *(const f32x4*)(qg + 16 * d2 + 8 * hi + 4);
                float o1[8], o2[8];
#pragma unroll
                for (int j = 0; j < 8; ++j) { const float y1 = bf2f(qr[d1][j]) * rstd * (j < 4 ? g1a[j & 3] : g1b[j & 3]), y2 = bf2f(qr[d2][j]) * rstd * (j < 4 ? g2a[j & 3] : g2b[j & 3]);
                    o1[j] = y1 * cs_[j] - y2 * sn_[j]; o2[j] = y2 * cs_[j] + y1 * sn_[j]; }
                u32x4 w1, w2; w1.x = cvt_pk_bf16(o1[0], o1[1]); w1.y = cvt_pk_bf16(o1[2], o1[3]); w1.z = cvt_pk_bf16(o1[4], o1[5]); w1.w = cvt_pk_bf16(o1[6], o1[7]);
                w2.x = cvt_pk_bf16(o2[0], o2[1]); w2.y = cvt_pk_bf16(o2[2], o2[3]); w2.z = cvt_pk_bf16(o2[4], o2[5]); w2.w = cvt_pk_bf16(o2[6], o2[7]);
                qr[d1] = __builtin_bit_cast(bf16x8, w1); qr[d2] = __builtin_bit_cast(bf16x8, w2); } }
    }
    const int sr = tid >> 4, sc = (tid & 15) * 8, vst0 = v_st(sr, sc), vst1 = v_st(32 + sr, sc);
    const int vb0 = (int)(uintptr_t)V_lds + v_rd_base(lane);
    struct { bf16x8 vs0, vs1, ks0, ks1; } sr_[2];
    const unsigned kvoff = (unsigned)(sr * LDK + sc) * 2u;
#define SLOAD(i, k0) do { const char* _vb = (const char*)Vh + (size_t)(k0) * (LDK * 2); const char* _kb = (const char*)Kh + (size_t)(k0) * (LDK * 2); \
    sr_[i].vs0 = *(const bf16x8*)(_vb + kvoff); sr_[i].vs1 = *(const bf16x8*)(_vb + (size_t)(32 * LDK * 2) + kvoff); \
    sr_[i].ks0 = *(const bf16x8*)(_kb + kvoff); sr_[i].ks1 = *(const bf16x8*)(_kb + (size_t)(32 * LDK * 2) + kvoff); } while (0)
#define SWRITE(b, i) do { *(bf16x8*)(V_lds + (b) * SHM_V + vst0) = sr_[i].vs0;          \
    *(bf16x8*)(V_lds + (b) * SHM_V + vst1) = sr_[i].vs1; int kc = sc * 2;               \
    *(bf16x8*)(K_lds + (b) * SHM_K + KSWZ(sr, kc)) = sr_[i].ks0;                       \
    *(bf16x8*)(K_lds + (b) * SHM_K + KSWZ(32 + sr, kc)) = sr_[i].ks1; } while (0)
#define SWAIT() asm volatile("s_waitcnt vmcnt(4)" ::: "memory")
#define RESC(a) do { if (__any((a) < 1.f)) { if (hi == 0) al_l[r32] = (a); asm volatile("s_waitcnt lgkmcnt(0)" ::: "memory"); \
    _Pragma("unroll") for (int d = 0; d < 4; ++d) _Pragma("unroll") for (int r = 0; r < 16; ++r) o[d][r] *= al_l[crow(r, hi)]; } } while (0)
    f32x16 pA0, pA1, pB0, pB1; float mnA, mnB, alA, alB; bf16x8 pa0, pa1, pa2, pa3; const int NT = seq / 64;
    constexpr int SE = 0, SO = 1;
    SLOAD(SE, 0); asm volatile("s_waitcnt vmcnt(0)" ::: "memory"); SWRITE(0, SE); __syncthreads();
    qkt(pA0, pA1, K_lds, qr, r32, hi); partialSM(pA0, pA1, m_reg, mnA, alA);
    SLOAD(SO, 64); if (2 < NT) SLOAD(SE, 2 * 64);
    SWAIT(); SWRITE(1, SO); __syncthreads();
    for (int j = 1; j + 1 < NT; j += 2) {
        SBAR(); qkt(pB0, pB1, K_lds + SHM_K, qr, r32, hi);
        finishSM(pA0, pA1, alA, l_reg, pa0, pa1, pa2, pa3); SBAR();
        SLOAD(SO, (j + 2) * 64); SBAR();
        pv_d0(o, vb0, pa0, pa1, pa2, pa3); partialSM(pB0, pB1, m_reg, mnB, alB);
        __syncthreads(); SWAIT(); SWRITE(0, SE);
        RESC(alB); __syncthreads();
        SBAR(); qkt(pA0, pA1, K_lds, qr, r32, hi);
        finishSM(pB0, pB1, alB, l_reg, pa0, pa1, pa2, pa3); SBAR();
        if (j + 3 < NT) SLOAD(SE, (j + 3) * 64); SBAR();
        pv_d0(o, vb0 + SHM_V, pa0, pa1, pa2, pa3); partialSM(pA0, pA1, m_reg, mnA, alA);
        __syncthreads(); SWAIT(); SWRITE(1, SO);
        RESC(alA); __syncthreads();
    }
    SBAR(); qkt(pB0, pB1, K_lds + SHM_K, qr, r32, hi);
    finishSM(pA0, pA1, alA, l_reg, pa0, pa1, pa2, pa3); SBAR();
    pv_d0(o, vb0, pa0, pa1, pa2, pa3); partialSM(pB0, pB1, m_reg, mnB, alB);
    __syncthreads(); RESC(alB);
    finishSM(pB0, pB1, alB, l_reg, pa0, pa1, pa2, pa3); SBAR();
    pv_d0(o, vb0 + SHM_V, pa0, pa1, pa2, pa3);
    const int hi_e = lane_id() >> 5;
    if (hi_e == 0) li_l[r32] = l_reg; asm volatile("s_waitcnt lgkmcnt(0)" ::: "memory");
    float rli[16];
#pragma unroll
    for (int r = 0; r < 16; ++r) rli[r] = __builtin_amdgcn_rcpf(li_l[crow(r, hi_e)]);
    bf16_t* Ow = Ob + (long)(wid * 32) * LDO;
#pragma unroll
    for (int r = 0; r < 16; ++r) { int orow = crow(r, hi_e);
#pragma unroll
        for (int d0 = 0; d0 < 4; ++d0) Ow[(long)orow * LDO + d0 * 32 + r32] = (bf16_t)(cvt_pk_bf16(o[d0][r] * rli[r], 0.f) & 0xffffu); }
    __syncthreads();
#undef SLOAD
#undef SWRITE
#undef SWAIT
#undef RESC
}
__device__ __forceinline__ void k8_prepass_phase(const bf16_t* QKV, unsigned char* k8, const float* kg, const f32x2* T1, int G, int c, int wv) {
    const int tid = fresh_tid(wv), lane = tid & 63, wave = __builtin_amdgcn_readfirstlane(tid >> 6), i16 = lane & 15, grp = lane >> 4, kvh = grp & 1;
    float gk[8];
#pragma unroll
    for (int k = 0; k < 8; ++k) gk[k] = kg[8 * i16 + k];
    const bool second = (i16 >> 2) & 1;
    for (int r0 = (c * 8 + wave) * 8; r0 < MT; r0 += G * 64) {
        bf16x8 xv[4]; f32x4 tb[4][4];
#pragma unroll
        for (int st = 0; st < 4; ++st) { const int row = r0 + 2 * st + (grp >> 1), t = row % SEQ, pos = (i16 < 8) ? (t >> 6) : (t & 63);
            xv[st] = *(const bf16x8*)(QKV + (size_t)row * 1536 + 1024 + kvh * 128 + 8 * i16);
            const f32x4* tp = (const f32x4*)(T1 + pos * 32 + 8 * (i16 & 3));
#pragma unroll
            for (int j = 0; j < 4; ++j) tb[st][j] = tp[j]; }
        asm volatile("" ::: "memory");
#pragma unroll
        for (int st = 0; st < 4; ++st) { const int row = r0 + 2 * st + (grp >> 1), t = row % SEQ, b = row / SEQ;
            float y[8]; float ss = 0.f;
#pragma unroll
            for (int k = 0; k < 8; ++k) { y[k] = bf2f(xv[st][k]); ss += y[k] * y[k]; }
            ss = row16_sum(ss);
            const float rstd = 1.0f / sqrtf(ss * (1.0f / 128.0f) + EPS);
#pragma unroll
            for (int k = 0; k < 8; ++k) y[k] = y[k] * rstd * gk[k];
            float o[8];
#pragma unroll
            for (int k = 0; k < 8; ++k) { const float py = shfl_xor_l(y[k], 4, lane); const float cs = tb[st][k >> 1][(k & 1) * 2], sn = tb[st][k >> 1][(k & 1) * 2 + 1];
                o[k] = second ? (y[k] * cs + py * sn) : (y[k] * cs - py * sn); }
            u32x2 q8; q8.x = cvt_pk4_fp8(o[0] * 4.f, o[1] * 4.f, o[2] * 4.f, o[3] * 4.f); q8.y = cvt_pk4_fp8(o[4] * 4.f, o[5] * 4.f, o[6] * 4.f, o[7] * 4.f);
            *(u32x2*)(k8 + ((size_t)(b * 2 + kvh) * SEQ + t) * 128 + 64 * (i16 >> 3) + 32 * (i16 & 1) + 8 * ((i16 >> 1) & 3)) = q8; }
    }
}
__device__ __forceinline__ void vt8_phase(const bf16_t* QKV, unsigned char* VT8, char* lds, int G, int c, int wv) {
    const int tid = fresh_tid(wv);
    constexpr int NU = 16 * (SEQ / 64);
    bf16x8 nx[2];
#define VT8_LOAD(U) do { const int _bk = (U) / (SEQ / 64), _tile = (U) % (SEQ / 64), _b = _bk >> 1, _kvh = _bk & 1; \
        _Pragma("unroll") for (int it = 0; it < 2; ++it) { const int pc = tid + 512 * it, key = pc >> 4, c8 = pc & 15; \
            nx[it] = *(const bf16x8*)(QKV + ((size_t)_b * SEQ + 64 * _tile + key) * 1536 + 1280 + _kvh * 128 + 8 * c8); } } while (0)
    if (c < NU) VT8_LOAD(c);
    for (int u = c; u < NU; u += G) { const int bk = u / (SEQ / 64), tile = u % (SEQ / 64);
#pragma unroll
        for (int it = 0; it < 2; ++it) { const int pc = tid + 512 * it, key = pc >> 4, c8 = pc & 15; *(bf16x8*)(lds + key * 272 + c8 * 16) = nx[it]; }
        if (u + G < NU) VT8_LOAD(u + G);
        __syncthreads();
        { const int col = tid >> 2, part = tid & 3, g = part >> 1, t = part & 1; float v[16];
#pragma unroll
          for (int r = 0; r < 16; ++r) { const int key = 32 * t + (r & 3) + 8 * (r >> 2) + 4 * g; v[r] = 4.f * bf2f(*(const short*)(lds + key * 272 + col * 2)); }
          u32x4 w; w.x = cvt_pk4_fp8(v[0], v[1], v[2], v[3]); w.y = cvt_pk4_fp8(v[4], v[5], v[6], v[7]); w.z = cvt_pk4_fp8(v[8], v[9], v[10], v[11]); w.w = cvt_pk4_fp8(v[12], v[13], v[14], v[15]);
          *(u32x4*)(VT8 + ((size_t)(bk * (SEQ / 64) + tile) * 128 + col) * 64 + part * 16) = w; }
        __syncthreads();
    }
#undef VT8_LOAD
}
constexpr int A8_K = 8192, A8_V = 128 * 80, A8_VOFF = 2 * A8_K, A8_WS = A8_VOFF + 2 * A8_V;
constexpr float A8_THR = 5.f;
__device__ __forceinline__ v8i cat8(u32x4 a, u32x4 b) { return (v8i){(int)a.x, (int)a.y, (int)a.z, (int)a.w, (int)b.x, (int)b.y, (int)b.z, (int)b.w}; }
__device__ __forceinline__ unsigned cvt_pk4_bf8(float a, float b, float c, float d) { int w = 0; w = __builtin_amdgcn_cvt_pk_bf8_f32(a, b, w, false); w = __builtin_amdgcn_cvt_pk_bf8_f32(c, d, w, true); return (unsigned)w; }
typedef short v2s_t __attribute__((ext_vector_type(2)));
__device__ __forceinline__ unsigned cvt_pk4_bf8_sc(float a, float b, float c, float d, float sc) { v2s_t w = {0, 0}; w = __builtin_amdgcn_cvt_scalef32_pk_bf8_f32(w, a, b, sc, false); w = __builtin_amdgcn_cvt_scalef32_pk_bf8_f32(w, c, d, sc, true); return __builtin_bit_cast(unsigned, w); }
template <bool FIRST>
__device__ __forceinline__ void partialSM8(f32x16& p0, f32x16& p1, float& n_reg, float& sc_reg, float& alpha) {
    constexpr float THRL = A8_THR * 1.4426950408889634f;
    float tmax = p0[0];
#pragma unroll
    for (int r = 1; r < 16; ++r) tmax = fmaxf(tmax, p0[r]);
#pragma unroll
    for (int r = 0; r < 16; ++r) tmax = fmaxf(tmax, p1[r]);
    { auto rr = __builtin_amdgcn_permlane32_swap(__float_as_uint(tmax), __float_as_uint(tmax), false, false);
      tmax = fmaxf(__uint_as_float(rr[0]), __uint_as_float(rr[1])); }
    if (!FIRST && __builtin_expect(__all(tmax - n_reg <= THRL), 1)) alpha = 1.f;
    else { const float nn = FIRST ? ceilf(tmax) : fmaxf(n_reg, ceilf(tmax)); alpha = FIRST ? 1.f : __builtin_amdgcn_exp2f(n_reg - nn); n_reg = nn; sc_reg = __builtin_amdgcn_exp2f(nn - 5.0f); }
#pragma unroll
    for (int r = 0; r < 16; ++r) p0[r] = __builtin_amdgcn_exp2f(p0[r]);
}
__device__ __forceinline__ void finishSM8(f32x16& p0, f32x16& p1, float sc, v8i& pa) {
#pragma unroll
    for (int r = 0; r < 16; ++r) p1[r] = __builtin_amdgcn_exp2f(p1[r]);
    pa = (v8i){(int)cvt_pk4_bf8_sc(p0[0], p0[1], p0[2], p0[3], sc), (int)cvt_pk4_bf8_sc(p0[4], p0[5], p0[6], p0[7], sc),
               (int)cvt_pk4_bf8_sc(p0[8], p0[9], p0[10], p0[11], sc), (int)cvt_pk4_bf8_sc(p0[12], p0[13], p0[14], p0[15], sc),
               (int)cvt_pk4_bf8_sc(p1[0], p1[1], p1[2], p1[3], sc), (int)cvt_pk4_bf8_sc(p1[4], p1[5], p1[6], p1[7], sc),
               (int)cvt_pk4_bf8_sc(p1[8], p1[9], p1[10], p1[11], sc), (int)cvt_pk4_bf8_sc(p1[12], p1[13], p1[14], p1[15], sc)};
}
__device__ __forceinline__ void qkt8(f32x16& p0, f32x16& p1, const char* Ks, const v8i (&qf)[2], int r32, int hi) {
    p0 = f32x16{}; p1 = f32x16{};
#pragma unroll
    for (int ks = 0; ks < 2; ++ks) { const int g0 = ks * 4 + hi * 2;
        const v8i a0 = cat8(*(const u32x4*)(Ks + r32 * 128 + (((g0) ^ ((r32 >> 1) & 7)) << 4)), *(const u32x4*)(Ks + r32 * 128 + (((g0 + 1) ^ ((r32 >> 1) & 7)) << 4)));
        const v8i a1 = cat8(*(const u32x4*)(Ks + (32 + r32) * 128 + (((g0) ^ ((r32 >> 1) & 7)) << 4)), *(const u32x4*)(Ks + (32 + r32) * 128 + (((g0 + 1) ^ ((r32 >> 1) & 7)) << 4)));
        p0 = __builtin_amdgcn_mfma_scale_f32_32x32x64_f8f6f4(a0, qf[ks], p0, 0, 0, 0, 0x7D7D7D7D, 0, 0x7A7A7A7A);
        p1 = __builtin_amdgcn_mfma_scale_f32_32x32x64_f8f6f4(a1, qf[ks], p1, 0, 0, 0, 0x7D7D7D7D, 0, 0x7A7A7A7A); }
}
__device__ __forceinline__ void pv8(f32x16* o, f32x16& lacc, const char* Vs, const v8i pa, int r32, int hi) {
    v8i vf[4];
#pragma unroll
    for (int d0 = 0; d0 < 4; ++d0) vf[d0] = cat8(*(const u32x4*)(Vs + (32 * d0 + r32) * 80 + hi * 32), *(const u32x4*)(Vs + (32 * d0 + r32) * 80 + hi * 32 + 16));
    asm volatile("s_waitcnt lgkmcnt(0)" ::: "memory"); SBAR();
#pragma unroll
    for (int d0 = 0; d0 < 4; ++d0) o[d0] = __builtin_amdgcn_mfma_scale_f32_32x32x64_f8f6f4(pa, vf[d0], o[d0], 1, 0, 0, 0x7A7A7A7A, 0, 0x7D7D7D7D);
    { const v8i ones = {0x48484848, 0x48484848, 0x48484848, 0x48484848, 0x48484848, 0x48484848, 0x48484848, 0x48484848};
      lacc = __builtin_amdgcn_mfma_scale_f32_32x32x64_f8f6f4(pa, ones, lacc, 1, 0, 0, 0x7A7A7A7A, 0, 0x7D7D7D7D); }
}
template <int LDQ, int LDO>
__device__ __forceinline__ void attn_fp8_body(const bf16_t* __restrict__ Qb, const unsigned char* __restrict__ K8h, const unsigned char* __restrict__ VT8h, bf16_t* __restrict__ Ob, int seq, char* lds, int wv,
                                              const float* qg, const f32x2* T1, int tq0) {
    const int tid = fresh_tid(wv), wid = __builtin_amdgcn_readfirstlane(tid >> 6), lane = tid & 63, r32 = lane & 31, hi = lane >> 5;
    char* K_lds = lds; char* V_lds = lds + A8_VOFF;
    float* wsp = (float*)(lds + A8_WS) + wid * 64; float* li_l = wsp; float* al_l = wsp + 32;
    v8i qf[2];
    {
        bf16x8 qr[8];
        const bf16_t* Qw = Qb + (long)(wid * 32 + r32) * LDQ + hi * 8;
#pragma unroll
        for (int d0 = 0; d0 < 8; ++d0) qr[d0] = *(const bf16x8*)(Qw + d0 * 16);
        float ss = 0.f;
#pragma unroll
        for (int d0 = 0; d0 < 8; ++d0)
#pragma unroll
            for (int j = 0; j < 8; ++j) { const float x = bf2f(qr[d0][j]); ss += x * x; }
        { auto rr = __builtin_amdgcn_permlane32_swap(__float_as_uint(ss), __float_as_uint(ss), false, false); ss = __uint_as_float(rr[0]) + __uint_as_float(rr[1]); }
        const float rstd = (4.0f * 8.0f * ATT_SCALE * 1.4426950408889634f) / sqrtf(ss * (1.0f / 128.0f) + EPS);
        const int t = tq0 + wid * 32 + r32;
        unsigned qb8[8][2];
#pragma unroll
        for (int hf = 0; hf < 2; ++hf) { const int pos = hf ? (t & 63) : (t >> 6);
#pragma unroll
            for (int a = 0; a < 2; ++a) { const int d1 = 4 * hf + a, d2 = d1 + 2;
                const f32x4* tp = (const f32x4*)(T1 + pos * 32 + 16 * a + 8 * hi); const f32x4 c01 = tp[0], c23 = tp[1], c45 = tp[2], c67 = tp[3];
                const float cs_[8] = {c01[0], c01[2], c23[0], c23[2], c45[0], c45[2], c67[0], c67[2]}, sn_[8] = {c01[1], c01[3], c23[1], c23[3], c45[1], c45[3], c67[1], c67[3]};
                const f32x4 g1a = *(const f32x4*)(qg + 16 * d1 + 8 * hi), g1b = *(const f32x4*)(qg + 16 * d1 + 8 * hi + 4), g2a = *(const f32x4*)(qg + 16 * d2 + 8 * hi), g2b = *(const f32x4*)(qg + 16 * d2 + 8 * hi + 4);
                float o1[8], o2[8];
#pragma unroll
                for (int j = 0; j < 8; ++j) { const float y1 = bf2f(qr[d1][j]) * rstd * (j < 4 ? g1a[j & 3] : g1b[j & 3]), y2 = bf2f(qr[d2][j]) * rstd * (j < 4 ? g2a[j & 3] : g2b[j & 3]);
                    o1[j] = y1 * cs_[j] - y2 * sn_[j]; o2[j] = y2 * cs_[j] + y1 * sn_[j]; }
                qb8[d1][0] = cvt_pk4_fp8(o1[0], o1[1], o1[2], o1[3]); qb8[d1][1] = cvt_pk4_fp8(o1[4], o1[5], o1[6], o1[7]);
                qb8[d2][0] = cvt_pk4_fp8(o2[0], o2[1], o2[2], o2[3]); qb8[d2][1] = cvt_pk4_fp8(o2[4], o2[5], o2[6], o2[7]);
                asm volatile("" ::: "memory"); __builtin_amdgcn_sched_barrier(0); } }
#pragma unroll
        for (int ks = 0; ks < 2; ++ks) qf[ks] = (v8i){(int)qb8[4 * ks][0], (int)qb8[4 * ks][1], (int)qb8[4 * ks + 1][0], (int)qb8[4 * ks + 1][1], (int)qb8[4 * ks + 2][0], (int)qb8[4 * ks + 2][1], (int)qb8[4 * ks + 3][0], (int)qb8[4 * ks + 3][1]};
    }
    float n_reg = 0.f, sc_reg = 1.f; f32x16 o[4] = {}; f32x16 lacc = {};
    const int kkey = tid >> 3, kst = kkey * 128 + (((tid & 7) ^ ((kkey >> 1) & 7)) << 4), vst = (tid >> 2) * 80 + (tid & 3) * 16;
    const unsigned koff = (unsigned)tid * 16u;
    struct { u32x4 ks, vs; } sr_[2];
#define SLOAD(i, tl) do { sr_[i].ks = *(const u32x4*)((const char*)K8h + (size_t)(tl) * 8192 + koff); sr_[i].vs = *(const u32x4*)((const char*)VT8h + (size_t)(tl) * 8192 + koff); } while (0)
#define SWRITE(b, i) do { *(u32x4*)(K_lds + (b) * A8_K + kst) = sr_[i].ks; *(u32x4*)(V_lds + (b) * A8_V + vst) = sr_[i].vs; } while (0)
#define SWAIT() asm volatile("s_waitcnt vmcnt(2)" ::: "memory")
#define RESC(a) do { if (__any((a) < 1.f)) { if (hi == 0) al_l[r32] = (a); asm volatile("s_waitcnt lgkmcnt(0)" ::: "memory"); \
    _Pragma("unroll") for (int r = 0; r < 16; ++r) { const float _a = al_l[crow(r, hi)]; lacc[r] *= _a; _Pragma("unroll") for (int d = 0; d < 4; ++d) o[d][r] *= _a; } } } while (0)
    f32x16 pA0, pA1, pB0, pB1; float alA, alB; v8i pa; const int NT = seq / 64;
    constexpr int SE = 0, SO = 1;
    SLOAD(SE, 0); asm volatile("s_waitcnt vmcnt(0)" ::: "memory"); SWRITE(0, SE); __syncthreads();
    qkt8(pA0, pA1, K_lds, qf, r32, hi); partialSM8<true>(pA0, pA1, n_reg, sc_reg, alA);
    SLOAD(SO, 1); if (2 < NT) SLOAD(SE, 2);
    SWAIT(); SWRITE(1, SO); __syncthreads();
    for (int j = 1; j + 1 < NT; j += 2) {
        SBAR(); qkt8(pB0, pB1, K_lds + A8_K, qf, r32, hi);
        finishSM8(pA0, pA1, sc_reg, pa); SBAR();
        SLOAD(SO, j + 2); SBAR();
        pv8(o, lacc, V_lds, pa, r32, hi); partialSM8<false>(pB0, pB1, n_reg, sc_reg, alB);
        __syncthreads(); SWAIT(); SWRITE(0, SE);
        RESC(alB); __syncthreads();
        SBAR(); qkt8(pA0, pA1, K_lds, qf, r32, hi);
        finishSM8(pB0, pB1, sc_reg, pa); SBAR();
        if (j + 3 < NT) SLOAD(SE, j + 3); SBAR();
        pv8(o, lacc, V_lds + A8_V, pa, r32, hi); partialSM8<false>(pA0, pA1, n_reg, sc_reg, alA);
        __syncthreads(); SWAIT(); SWRITE(1, SO);
        RESC(alA); __syncthreads();
    }
    SBAR(); qkt8(pB0, pB1, K_lds + A8_K, qf, r32, hi);
    finishSM8(pA0, pA1, sc_reg, pa); SBAR();
    pv8(o, lacc, V_lds, pa, r32, hi); partialSM8<false>(pB0, pB1, n_reg, sc_reg, alB);
    __syncthreads(); RESC(alB);
    finishSM8(pB0, pB1, sc_reg, pa); SBAR();
    pv8(o, lacc, V_lds + A8_V, pa, r32, hi);
    const int hi_e = lane_id() >> 5;
    (void)li_l; (void)n_reg;
    float rli[16];
#pragma unroll
    for (int r = 0; r < 16; ++r) rli[r] = __builtin_amdgcn_rcpf(lacc[r]);
    const int lane_e = lane_id(), r32e = lane_e & 31;
#pragma unroll
    for (int r = 0; r < 16; ++r) { const unsigned oo = (unsigned)((wid * 32 + crow(r, hi_e)) * LDO + r32e) * 2u;
#pragma unroll
        for (int d0 = 0; d0 < 4; ++d0) *(bf16_t*)((char*)Ob + (oo + (unsigned)(d0 * 64))) = (bf16_t)(cvt_pk_bf16(o[d0][r] * rli[r], 0.f) & 0xffffu); }
    __syncthreads();
#undef SLOAD
#undef SWRITE
#undef SWAIT
#undef RESC
}
__device__ __forceinline__ void gqa_attn_phase(const bf16_t* QKV, bf16_t* AO, char* lds, int G, int c, int wv, const float* qg, const f32x2* T1, const unsigned char* K8, const unsigned char* VT8) {
    const int per = G / 8, x = c % 8, j = c / 8;
#pragma unroll 1
    for (int u = j; u < 2 * 128; u += per) {
        const int pair = x * 2 + u / 128, uip = u % 128, hg = uip / 32, qb = uip % 32;
        const int b = pair >> 1, kvh = pair & 1, h = kvh * 4 + hg;
        const size_t row0 = (size_t)b * SEQ;
        if (FP8_ATTN) attn_fp8_body<1536, 1024>(QKV + (row0 + qb * 256) * 1536 + h * 128, K8 + (size_t)pair * SEQ * 128, VT8 + (size_t)pair * SEQ * 128, AO + (row0 + qb * 256) * 1024 + h * 128, SEQ, lds, wv, qg, T1, qb * 256);
        else attn_dense_body<1536, 1536, 1024, true>(QKV + (row0 + qb * 256) * 1536 + h * 128, QKV + row0 * 1536 + 1024 + kvh * 128, QKV + row0 * 1536 + 1280 + kvh * 128,
                                                AO + (row0 + qb * 256) * 1024 + h * 128, SEQ, lds, wv, qg, T1, qb * 256);
    }
}

template <int KS> __device__ __forceinline__ void pv_band_step(f32x16* o, int vb, const bf16x8 pa) {
    const s16x4 l0 = tr_read<v_rd_off(0, KS, 0)>(vb), h0 = tr_read<v_rd_off(0, KS, 1)>(vb), l1 = tr_read<v_rd_off(1, KS, 0)>(vb), h1 = tr_read<v_rd_off(1, KS, 1)>(vb);
    const s16x4 l2 = tr_read<v_rd_off(2, KS, 0)>(vb), h2 = tr_read<v_rd_off(2, KS, 1)>(vb), l3 = tr_read<v_rd_off(3, KS, 0)>(vb), h3 = tr_read<v_rd_off(3, KS, 1)>(vb);
    asm volatile("s_waitcnt lgkmcnt(0)" ::: "memory"); SBAR();
    o[0] = __builtin_amdgcn_mfma_f32_32x32x16_bf16(pa, PKV(l0, h0), o[0], 0, 0, 0);
    o[1] = __builtin_amdgcn_mfma_f32_32x32x16_bf16(pa, PKV(l1, h1), o[1], 0, 0, 0);
    o[2] = __builtin_amdgcn_mfma_f32_32x32x16_bf16(pa, PKV(l2, h2), o[2], 0, 0, 0);
    o[3] = __builtin_amdgcn_mfma_f32_32x32x16_bf16(pa, PKV(l3, h3), o[3], 0, 0, 0);
}
constexpr int DIL_LI = 98304, DIL_TT = DIL_LI + 2048, DIL_LDS_END = DIL_TT + 384 * 128;
static_assert(DIL_LDS_END <= LDS_BYTES, "dilated attention LDS");
__device__ __forceinline__ void dil_attn_phase(const bf16_t* QKVD, bf16_t* OG, float* LSE, char* lds, int G, int c, int wv, const float* qg, const float* kg, const f32x2* T2) {
    const int tid0 = fresh_tid(wv), wid = __builtin_amdgcn_readfirstlane(tid0 >> 6);
    char* KV = lds;
    const char* TT = lds + DIL_TT;
    constexpr float C = ATT_SCALE * 1.4426950408889634f;
#if FP8_QKVD
    u32x2 kN[12], qN[8];
#define DIL_PREFETCH(UU, LANE) do { const int _u = (UU); const int _rp = _u & 31, _h = (_u >> 5) & 7, _g = (_u >> 8) % 3, _bl = _u / 768; \
        const int _dsh = 2 * _g, _dil = 1 << _dsh, _nbk = 32 >> _dsh, _r = _rp / _nbk, _pb = _rp % _nbk, _Mres = SEQ >> _dsh; \
        const char* _bb = (const char*)QKVD + ((size_t)_bl * SEQ * DIL_N + _g * 3072 + _h * 128); \
        const int _tid = (wid << 6) | (LANE), _c16 = _tid & 15, _rb = _tid >> 4, _r32 = (LANE) & 31, _hi = (LANE) >> 5; \
        _Pragma("unroll") for (int it = 0; it < 12; ++it) { int _p = 256 * _pb - 64 + _rb + 32 * it; _p = _p < 0 ? 0 : (_p >= _Mres ? _Mres - 1 : _p); \
            kN[it] = *(const u32x2*)(_bb + ((unsigned)(_r + _dil * _p) * (unsigned)DIL_N + (unsigned)(1024 + _c16 * 8))); } \
        const unsigned _qo = (unsigned)(_r + _dil * (256 * _pb + 32 * wid + _r32)) * (unsigned)DIL_N + (unsigned)(_hi * 8); \
        _Pragma("unroll") for (int d0 = 0; d0 < 8; ++d0) qN[d0] = *(const u32x2*)(_bb + (_qo + (unsigned)(d0 * 16))); } while (0)
    if (c < DIL_CB * 3 * 8 * 32) { int l0 = tid0 & 63; asm volatile("" : "+v"(l0)); DIL_PREFETCH(c, l0); }
#endif
#pragma unroll 1
    for (int u = c; u < DIL_CB * 3 * 8 * 32; u += G) {
        int lane_l = tid0 & 63; asm volatile("" : "+v"(lane_l));
        const int lane = lane_l, tid = (wid << 6) | lane, r32 = lane & 31, hi = lane >> 5, c16 = tid & 15, rbase = tid >> 4;
        float* li_l = (float*)(lds + DIL_LI) + wid * 64;
        const int rp = u & 31, h = (u >> 5) & 7, g = (u >> 8) % 3, bl = u / 768;
        const int dsh = 2 * g, dil = 1 << dsh, nbk = 32 >> dsh, r = rp / nbk, pb = rp % nbk, Mres = SEQ >> dsh;
        constexpr int QES = FP8_QKVD ? 1 : 2;
        const char* baseb = (const char*)QKVD + ((size_t)bl * SEQ * DIL_N + g * 3072 + h * 128) * QES;
#define DIL_LD8(DST, OFF) do { if (FP8_QKVD) { const u32x2 _w = *(const u32x2*)(baseb + (OFF)); \
            DST[0] = __builtin_amdgcn_cvt_f32_fp8((int)_w.x, 0); DST[1] = __builtin_amdgcn_cvt_f32_fp8((int)_w.x, 1); DST[2] = __builtin_amdgcn_cvt_f32_fp8((int)_w.x, 2); DST[3] = __builtin_amdgcn_cvt_f32_fp8((int)_w.x, 3); \
            DST[4] = __builtin_amdgcn_cvt_f32_fp8((int)_w.y, 0); DST[5] = __builtin_amdgcn_cvt_f32_fp8((int)_w.y, 1); DST[6] = __builtin_amdgcn_cvt_f32_fp8((int)_w.y, 2); DST[7] = __builtin_amdgcn_cvt_f32_fp8((int)_w.y, 3); } \
          else { const bf16x8 _v = *(const bf16x8*)(baseb + (OFF)); _Pragma("unroll") for (int _k = 0; _k < 8; ++_k) DST[_k] = bf2f(_v[_k]); } } while (0)
        const int p0 = 256 * pb + 32 * wid;
#pragma unroll
        for (int jj = 0; jj < 6; ++jj) { const int i = tid + 512 * jj, lr = i >> 3, part = i & 7; int p = 256 * pb - 64 + lr; p = p < 0 ? 0 : (p >= Mres ? Mres - 1 : p);
            __builtin_amdgcn_global_load_lds((const unsigned*)((const char*)T2 + (size_t)(r + dil * p) * 128 + part * 16), (LAS unsigned*)(lds + DIL_TT + (wid * 64 + 512 * jj) * 16), 16, 0, 0); }
        u32x4 kreg[12];
#if FP8_QKVD
#pragma unroll
        for (int it = 0; it < 12; ++it) kreg[it] = (u32x4){kN[it].x, kN[it].y, 0u, 0u};
#else
#pragma unroll
        for (int it = 0; it < 12; ++it) { const int lr = rbase + 32 * it, p = 256 * pb - 64 + lr; kreg[it] = (u32x4){0u, 0u, 0u, 0u};
            if (p >= 0 && p < Mres) { const unsigned ko = (unsigned)(r + dil * p) * (unsigned)(DIL_N * QES) + (unsigned)((1024 + c16 * 8) * QES);
                if (FP8_QKVD) { const u32x2 w = *(const u32x2*)(baseb + ko); kreg[it].x = w.x; kreg[it].y = w.y; } else kreg[it] = *(const u32x4*)(baseb + ko); } }
#endif
        u32x4 qraw[8];
#if FP8_QKVD
#pragma unroll
        for (int d0 = 0; d0 < 8; ++d0) qraw[d0] = (u32x4){qN[d0].x, qN[d0].y, 0u, 0u};
#else
        { const unsigned qo = (unsigned)(r + dil * (p0 + r32)) * (unsigned)(DIL_N * QES) + (unsigned)(hi * 8 * QES);
#pragma unroll
          for (int d0 = 0; d0 < 8; ++d0) { if (FP8_QKVD) { const u32x2 w = *(const u32x2*)(baseb + (qo + (unsigned)(d0 * 16))); qraw[d0] = (u32x4){w.x, w.y, 0u, 0u}; } else qraw[d0] = *(const u32x4*)(baseb + (qo + (unsigned)(d0 * 32))); } }
#endif
        bf16x8 qr[8];
#define DIL_UNPK(DST, RAW) do { if (FP8_QKVD) { \
            DST[0] = __builtin_amdgcn_cvt_f32_fp8((int)(RAW).x, 0); DST[1] = __builtin_amdgcn_cvt_f32_fp8((int)(RAW).x, 1); DST[2] = __builtin_amdgcn_cvt_f32_fp8((int)(RAW).x, 2); DST[3] = __builtin_amdgcn_cvt_f32_fp8((int)(RAW).x, 3); \
            DST[4] = __builtin_amdgcn_cvt_f32_fp8((int)(RAW).y, 0); DST[5] = __builtin_amdgcn_cvt_f32_fp8((int)(RAW).y, 1); DST[6] = __builtin_amdgcn_cvt_f32_fp8((int)(RAW).y, 2); DST[7] = __builtin_amdgcn_cvt_f32_fp8((int)(RAW).y, 3); } \
          else { const bf16x8 _v = __builtin_bit_cast(bf16x8, (RAW)); _Pragma("unroll") for (int _k = 0; _k < 8; ++_k) DST[_k] = bf2f(_v[_k]); } } while (0)
        const f32x4 gk0 = *(const f32x4*)(kg + 8 * c16), gk1 = *(const f32x4*)(kg + 8 * c16 + 4);
        asm volatile("s_waitcnt vmcnt(0)" ::: "memory");
        __syncthreads();
#pragma unroll
        for (int it = 0; it < 12; ++it) { const int lr = rbase + 32 * it;
            float y[8]; float ss = 0.f; DIL_UNPK(y, kreg[it]);
#pragma unroll
            for (int k = 0; k < 8; ++k) ss += y[k] * y[k];
            ss = row16_sum(ss);
            const float rstd = 1.0f / sqrtf(ss * (1.0f / 128.0f) + EPS);
#pragma unroll
            for (int k = 0; k < 8; ++k) y[k] *= rstd * (k < 4 ? gk0[k & 3] : gk1[k & 3]);
            const f32x4* tp = (const f32x4*)(TT + lr * 128 + (c16 & 1) * 64); const f32x4 t0 = tp[0], t1 = tp[1], t2 = tp[2], t3 = tp[3];
            const float cs_[8] = {t0[0], t0[2], t1[0], t1[2], t2[0], t2[2], t3[0], t3[2]}, sn_[8] = {t0[1], t0[3], t1[1], t1[3], t2[1], t2[3], t3[1], t3[3]};
            float o[8];
#pragma unroll
            for (int k = 0; k < 8; ++k) { const float py = dpp_mov<0x4E>(y[k]); const float rot = (c16 & 2) ? (y[k] * cs_[k] + py * sn_[k]) : (y[k] * cs_[k] - py * sn_[k]); o[k] = (c16 < 4) ? rot : y[k]; }
            u32x4 w; w.x = cvt_pk_bf16(o[0], o[1]); w.y = cvt_pk_bf16(o[2], o[3]); w.z = cvt_pk_bf16(o[4], o[5]); w.w = cvt_pk_bf16(o[6], o[7]);
            *(u32x4*)(KV + KSWZ(lr, c16 * 16)) = w; }
        { float ss = 0.f; float qx[8][8];
#pragma unroll
          for (int d0 = 0; d0 < 8; ++d0) { DIL_UNPK(qx[d0], qraw[d0]);
#pragma unroll
              for (int j = 0; j < 8; ++j) ss += qx[d0][j] * qx[d0][j]; }
          { auto rr = __builtin_amdgcn_permlane32_swap(__float_as_uint(ss), __float_as_uint(ss), false, false); ss = __uint_as_float(rr[0]) + __uint_as_float(rr[1]); }
          const float rstd = 1.0f / sqrtf(ss * (1.0f / 128.0f) + EPS);
          const f32x4* tp = (const f32x4*)(TT + (64 + 32 * wid + r32) * 128 + hi * 64); const f32x4 t0 = tp[0], t1 = tp[1], t2 = tp[2], t3 = tp[3];
          const float cs_[8] = {t0[0], t0[2], t1[0], t1[2], t2[0], t2[2], t3[0], t3[2]}, sn_[8] = {t0[1], t0[3], t1[1], t1[3], t2[1], t2[3], t3[1], t3[3]};
#pragma unroll
          for (int d0 = 0; d0 < 8; d0 += 2) { const f32x4 ga = *(const f32x4*)(qg + 16 * d0 + 8 * hi), gb = *(const f32x4*)(qg + 16 * d0 + 8 * hi + 4), gc = *(const f32x4*)(qg + 16 * d0 + 16 + 8 * hi), gd = *(const f32x4*)(qg + 16 * d0 + 16 + 8 * hi + 4);
              float o1[8], o2[8];
#pragma unroll
              for (int j = 0; j < 8; ++j) { const float y1 = qx[d0][j] * rstd * (j < 4 ? ga[j & 3] : gb[j & 3]), y2 = qx[d0 + 1][j] * rstd * (j < 4 ? gc[j & 3] : gd[j & 3]);
                  if (d0 == 0) { o1[j] = y1 * cs_[j] - y2 * sn_[j]; o2[j] = y2 * cs_[j] + y1 * sn_[j]; } else { o1[j] = y1; o2[j] = y2; } }
              u32x4 w1, w2; w1.x = cvt_pk_bf16(o1[0], o1[1]); w1.y = cvt_pk_bf16(o1[2], o1[3]); w1.z = cvt_pk_bf16(o1[4], o1[5]); w1.w = cvt_pk_bf16(o1[6], o1[7]);
              w2.x = cvt_pk_bf16(o2[0], o2[1]); w2.y = cvt_pk_bf16(o2[2], o2[3]); w2.z = cvt_pk_bf16(o2[4], o2[5]); w2.w = cvt_pk_bf16(o2[6], o2[7]);
              qr[d0] = __builtin_bit_cast(bf16x8, w1); qr[d0 + 1] = __builtin_bit_cast(bf16x8, w2); } }
        u32x4 vreg[12];
#pragma unroll
        for (int it = 0; it < 12; ++it) { const int lr = rbase + 32 * it, p = 256 * pb - 64 + lr; vreg[it] = (u32x4){0u, 0u, 0u, 0u};
            if (p >= 0 && p < Mres) { const unsigned vo = (unsigned)(r + dil * p) * (unsigned)(DIL_N * QES) + (unsigned)((2048 + c16 * 8) * QES);
                if (FP8_QKVD) { const u32x2 w = *(const u32x2*)(baseb + vo); vreg[it].x = w.x; vreg[it].y = w.y; } else vreg[it] = *(const u32x4*)(baseb + vo); } }
        __syncthreads();
#if FP8_QKVD
        if (u + G < DIL_CB * 3 * 8 * 32) DIL_PREFETCH(u + G, lane);
#endif
        f32x16 s[5];
#pragma unroll
        for (int kt = 0; kt < 5; ++kt) { s[kt] = f32x16{};
#pragma unroll
            for (int d0 = 0; d0 < 8; ++d0) { const int lr = 32 * wid + 32 * kt + r32; const bf16x8 a = *(const bf16x8*)(KV + KSWZ(lr, (d0 * 16 + hi * 8) * 2));
                s[kt] = __builtin_amdgcn_mfma_f32_32x32x16_bf16(a, qr[d0], s[kt], 0, 0, 0); } }
        float mx = -3.0e38f;
        const bool edge = (p0 - 64 < 0) || (p0 + 128 + 35 - 64 >= Mres);
        if (edge) {
#pragma unroll
            for (int kt = 0; kt < 5; ++kt)
#pragma unroll
                for (int rr = 0; rr < 16; ++rr) { const int kp = p0 + 32 * kt + crow(rr, hi) - 64; if (!((kp >= 0) && (kp < Mres))) s[kt][rr] = -3.0e38f; } }
#pragma unroll
        for (int rr = 0; rr < 16; ++rr) { if (crow(rr, hi) < r32) s[0][rr] = -3.0e38f; if (crow(rr, hi) > r32) s[4][rr] = -3.0e38f; }
#pragma unroll
        for (int kt = 0; kt < 5; ++kt)
#pragma unroll
            for (int rr = 0; rr < 16; ++rr) mx = fmaxf(mx, s[kt][rr]);
        { auto rr = __builtin_amdgcn_permlane32_swap(__float_as_uint(mx), __float_as_uint(mx), false, false); mx = fmaxf(__uint_as_float(rr[0]), __uint_as_float(rr[1])); }
        float l = 0.f; const float mC = -mx * C;
#pragma unroll
        for (int kt = 0; kt < 5; ++kt)
#pragma unroll
            for (int rr = 0; rr < 16; ++rr) { const float pv = (s[kt][rr] > -1.0e38f) ? __builtin_amdgcn_exp2f(fmaf(s[kt][rr], C, mC)) : 0.f; s[kt][rr] = pv; l += pv; }
        { auto rr = __builtin_amdgcn_permlane32_swap(__float_as_uint(l), __float_as_uint(l), false, false); l = __uint_as_float(rr[0]) + __uint_as_float(rr[1]); }
        bf16x8 pa[10];
#pragma unroll
        for (int kt = 0; kt < 5; ++kt) { PK4(s[kt], 0, pa[2 * kt]); PK4(s[kt], 8, pa[2 * kt + 1]); }
        __syncthreads();
#pragma unroll
        for (int it = 0; it < 12; ++it) { const int lr = rbase + 32 * it;
            if (FP8_QKVD) { float vv[8]; DIL_UNPK(vv, vreg[it]); u32x4 w; w.x = cvt_pk_bf16(vv[0] * 0.25f, vv[1] * 0.25f); w.y = cvt_pk_bf16(vv[2] * 0.25f, vv[3] * 0.25f); w.z = cvt_pk_bf16(vv[4] * 0.25f, vv[5] * 0.25f); w.w = cvt_pk_bf16(vv[6] * 0.25f, vv[7] * 0.25f);
                *(u32x4*)(KV + v_st(lr, c16 * 8)) = w; }
            else *(u32x4*)(KV + v_st(lr, c16 * 8)) = vreg[it]; }
        __syncthreads();
        f32x16 o[4] = {};
        const int vb = (int)(uintptr_t)KV + v_rd_base(lane) + 2 * wid * 4096;
        pv_band_step<0>(o, vb, pa[0]); pv_band_step<1>(o, vb, pa[1]); pv_band_step<2>(o, vb, pa[2]); pv_band_step<3>(o, vb, pa[3]); pv_band_step<4>(o, vb, pa[4]);
        pv_band_step<5>(o, vb, pa[5]); pv_band_step<6>(o, vb, pa[6]); pv_band_step<7>(o, vb, pa[7]); pv_band_step<8>(o, vb, pa[8]); pv_band_step<9>(o, vb, pa[9]);
        if (hi == 0) li_l[r32] = l; asm volatile("s_waitcnt lgkmcnt(0)" ::: "memory");
        bf16_t* og = OG + ((size_t)g * DIL_ROWS + (size_t)bl * SEQ) * DM + h * 128;
        { float rl[16];
#pragma unroll
          for (int rr = 0; rr < 16; ++rr) rl[rr] = __builtin_amdgcn_rcpf(li_l[crow(rr, hi)]);
          char* ot = lds + DIL_TT + wid * (32 * 144);
#pragma unroll
          for (int half = 0; half < 2; ++half) {
#pragma unroll
              for (int rr = 0; rr < 16; ++rr)
#pragma unroll
                  for (int dd = 0; dd < 2; ++dd) *(bf16_t*)(ot + crow(rr, hi) * 144 + (dd * 32 + r32) * 2) = (bf16_t)(cvt_pk_bf16(o[2 * half + dd][rr] * rl[rr], 0.f) & 0xffffu);
              asm volatile("s_waitcnt lgkmcnt(0)" ::: "memory");
#pragma unroll
              for (int j = 0; j < 4; ++j) { const int lrow = (lane >> 3) + 8 * j; const u32x4 w = *(const u32x4*)(ot + lrow * 144 + (lane & 7) * 16);
                  *(u32x4*)(og + (size_t)(r + dil * (p0 + lrow)) * DM + half * 64 + (lane & 7) * 8) = w; }
              asm volatile("s_waitcnt lgkmcnt(0)" ::: "memory"); } }
        if (hi == 0) LSE[((size_t)g * DIL_ROWS + (size_t)bl * SEQ + r + dil * (p0 + r32)) * 8 + h] = mx * ATT_SCALE + __logf(l);
        __syncthreads();
    }
}
#undef DIL_LD8
#undef DIL_UNPK
#undef DIL_PREFETCH
__device__ __forceinline__ void dil_merge_phase(const bf16_t* OG, const float* LSE, bf16_t* AO, unsigned char* AO8, int G, int c, int wv) {
    const int tid = fresh_tid(wv), lane = tid & 63, wave = __builtin_amdgcn_readfirstlane(tid >> 6), h = lane >> 3;
    for (int rowb = c * 8 + wave; rowb < DIL_ROWS; rowb += G * 8 * 4) {
        float ls[4][3]; bf16x8 og[4][3][2];
#pragma unroll
        for (int r = 0; r < 4; ++r) { const int row = rowb + r * G * 8;
            if (row < DIL_ROWS) {
#pragma unroll
                for (int g = 0; g < 3; ++g) { ls[r][g] = LSE[((size_t)g * DIL_ROWS + row) * 8 + h]; const bf16x8* p = (const bf16x8*)(OG + ((size_t)g * DIL_ROWS + row) * DM + lane * 16); og[r][g][0] = p[0]; og[r][g][1] = p[1]; } } }
        asm volatile("" ::: "memory");
#pragma unroll
        for (int r = 0; r < 4; ++r) { const int row = rowb + r * G * 8;
            if (row < DIL_ROWS) {
                const float mx = fmaxf(ls[r][0], fmaxf(ls[r][1], ls[r][2]));
                float w[3]; float sum = 0.f;
#pragma unroll
                for (int g = 0; g < 3; ++g) { w[g] = __expf(ls[r][g] - mx); sum += w[g]; }
                const float inv = 1.0f / sum;
                float acc[16];
#pragma unroll
                for (int k = 0; k < 16; ++k) acc[k] = 0.f;
#pragma unroll
                for (int g = 0; g < 3; ++g) { const bf16x8 a = og[r][g][0], b = og[r][g][1]; const float wg = w[g] * inv;
#pragma unroll
                    for (int k = 0; k < 8; ++k) { acc[k] += wg * bf2f(a[k]); acc[8 + k] += wg * bf2f(b[k]); } }
                u32x4 o0, o1; o0.x = cvt_pk_bf16(acc[0], acc[1]); o0.y = cvt_pk_bf16(acc[2], acc[3]); o0.z = cvt_pk_bf16(acc[4], acc[5]); o0.w = cvt_pk_bf16(acc[6], acc[7]);
                o1.x = cvt_pk_bf16(acc[8], acc[9]); o1.y = cvt_pk_bf16(acc[10], acc[11]); o1.z = cvt_pk_bf16(acc[12], acc[13]); o1.w = cvt_pk_bf16(acc[14], acc[15]);
                if (AO8) { constexpr float sc = (float)(1 << F8S_AO); u32x4 q; q.x = cvt_pk4_fp8(acc[0] * sc, acc[1] * sc, acc[2] * sc, acc[3] * sc); q.y = cvt_pk4_fp8(acc[4] * sc, acc[5] * sc, acc[6] * sc, acc[7] * sc);
                    q.z = cvt_pk4_fp8(acc[8] * sc, acc[9] * sc, acc[10] * sc, acc[11] * sc); q.w = cvt_pk4_fp8(acc[12] * sc, acc[13] * sc, acc[14] * sc, acc[15] * sc); *(u32x4*)(AO8 + (size_t)row * DM + lane * 16) = q; }
                else { u32x4* op = (u32x4*)(AO + (size_t)row * DM + lane * 16); op[0] = o0; op[1] = o1; } } }
    }
}

constexpr int GU_SW = e8m0x4(F8S_WGU), GU_SA = e8m0x4(F8S_HN), DN_SW = e8m0x4(F8S_WD), DN_SA = e8m0x4(F8S_HID), RES_SA = e8m0x4(F8S_AO);
constexpr unsigned ALL_KINDS = (1u << 23) - 1u;
enum { K_PRO = 0, K_WIN, K_RG0, K_RGC, K_RG1, K_QKV1, K_QKNA, K_GQA, K_QKV2, K_QKND, K_DIL, K_MRG, K_RES, K_CAST, K_GU, K_DN, K_NORMR, K_SCAT, K_MGU, K_MDN, K_MDR, K_NORMY, K_FIN, K_COUNT };
template <unsigned MASK>
__global__ void __launch_bounds__(512, 2) mega(Params p) {
    extern __shared__ __attribute__((aligned(16))) unsigned char lds_raw[];
    LAS unsigned char* lds = (LAS unsigned char*)lds_raw;
    const int wv = __builtin_amdgcn_readfirstlane((int)threadIdx.x >> 6);
    const int G0 = gridDim.x, c0 = blockIdx.x, lo = p.lo, hi = p.hi < PHASE_LIMIT ? p.hi : PHASE_LIMIT;
    XcdBarrier bar; bar.bar = (unsigned*)(p.ws + WS_CTL); bar.x = 0; bar.st = nullptr;
    if (MASK == ALL_KINDS && hi - lo > 1) {
        const bool t0 = fresh_tid(wv) == 0;
        if (t0) *(LAS u32x4*)(lds + LDS_BAR) = (u32x4){0u, 0u, 0u, 0u};
        __syncthreads();
        bar = xcd_barrier_post((unsigned*)(p.ws + WS_CTL), (volatile LAS unsigned*)(lds + LDS_BAR), t0);
    }
    int ph = 0;
#define PH_BEGIN(KIND) if (((MASK >> (KIND)) & 1u) && ph >= lo && ph < hi) { for (int _rep = 0; _rep <= (int)(((unsigned)(DUP_MASK) >> (KIND)) & 1u); ++_rep) { if (_rep) __syncthreads(); unsigned char* ws = fresh_ptr(p.ws); float* out = fresh_ptr(p.out); int G = G0, c = c0; asm volatile("" : "+s"(G), "+s"(c));   \
        bf16_t* WB = (bf16_t*)(ws + WS_WB); bf16_t* XB = (bf16_t*)(ws + WS_XB); unsigned char* BIG = ws + WS_BIG; pg8::ss_t* SS = (pg8::ss_t*)(ws + WS_SS); bf16_t* AOB = (bf16_t*)out; unsigned char* X8 = (unsigned char*)out + OUT_X8; \
        (void)out; (void)WB; (void)XB; (void)BIG; (void)SS; (void)AOB; (void)X8;
#define PH_END   } if (MASK == ALL_KINDS && ph + 1 < hi) { bar.bar = (unsigned*)(fresh_ptr(p.ws) + WS_CTL); xcd_barrier(bar, fresh_tid(wv) == 0); } } ++ph;

    PH_BEGIN(K_PRO) prologue_phase(p, lds, G, c, wv); PH_END

#pragma unroll 1
    for (int L = 0; L < 4; ++L) {
        if (L == 0 || L == 3) {
            const int ib = L ? 32 : 1;
#define RG_PTRS const bf16_t* Gw = WB + (L ? O_L3_GATE : O_L0_GATE); bf16_t* GY = (bf16_t*)BIG; bf16_t* XBR = (bf16_t*)(BIG + (size_t)MT * DM * 2); \
            float* SUMP = (float*)(ws + WS_SUMP); float* SUMH = (float*)(ws + WS_SUMH); float* CARRY = (float*)(ws + WS_CARRY); (void)Gw; (void)GY; (void)XBR; (void)SUMP; (void)SUMH; (void)CARRY;
            PH_BEGIN(K_WIN) { RG_PTRS const bf16_t* Win = WB + (L ? O_L3_WIN : O_L0_WIN);
                const bool f8w = (L == 0) ? (((FP8_WIN) & 1) != 0) : (((FP8_WIN) & 8) != 0);
                pg8::Sched S{f8w ? (const char*)X8 : (const char*)XB, (const char*)Win, 0, nullptr, nullptr, MT / 256, 8, G, c, 0, 0, (const char*)SS}; pg8::EpiWin E{GY, XBR};
                if (f8w) pg8::gemm_phase<pg8::EpiWin, false, GU_SW, GU_SA>(lds, 1024, S, E, wv); else pg8::gemm_phase<pg8::EpiWin, false>(lds, 1024, S, E, wv); } PH_END
            PH_BEGIN(K_RG0) { RG_PTRS rg_phase<0>(XBR, GY, AOB, nullptr, Gw, p.in[ib + 2], p.in[ib + 3], p.in[ib + 5], p.in[ib + 7], p.in[ib + 8], SUMP, SUMH, CARRY, lds, G, c, wv); } PH_END
            PH_BEGIN(K_RGC) { RG_PTRS rg_carry_phase(SUMP, SUMH, CARRY, lds, G, c, wv); } PH_END
            PH_BEGIN(K_RG1) { RG_PTRS rg_phase<1>(XBR, GY, AOB, ((((FP8_RES) & 1) && L == 0) || (((FP8_RES) & 8) && L == 3)) ? (unsigned char*)out + OUT_AO8 : nullptr, Gw, p.in[ib + 2], p.in[ib + 3], p.in[ib + 5], p.in[ib + 7], p.in[ib + 8], SUMP, SUMH, CARRY, lds, G, c, wv); } PH_END
#undef RG_PTRS
        } else if (L == 1) {
            PH_BEGIN(K_QKV1) { bf16_t* QKV = (bf16_t*)BIG; pg8::Sched S{FP8_QKV1 ? (const char*)X8 : (const char*)XB, (const char*)(WB + O_L1_QKV), 0, nullptr, nullptr, MT / 256, 6, G, c, 0, 0, (const char*)SS}; pg8::EpiBf16 E{QKV, 1536};
                if (FP8_QKV1) pg8::gemm_phase<pg8::EpiBf16, false, GU_SW, GU_SA>(lds, 1024, S, E, wv); else pg8::gemm_phase<pg8::EpiBf16, false>(lds, 1024, S, E, wv); } PH_END
            PH_BEGIN(K_QKNA) { bf16_t* QKV = (bf16_t*)BIG; unsigned char* K8 = BIG + 192 * MiB; unsigned char* VT8 = BIG + 208 * MiB;
                if (FP8_ATTN) k8_prepass_phase(QKV, K8, p.in[17], (const f32x2*)(ws + WS_T1), G, c, wv); else qknorm_rope_phase<true>(QKV, MT, 1536, 8, 10, p.in[16], p.in[17], G, c, wv, nullptr);
                if (FP8_ATTN) { __syncthreads(); vt8_phase(QKV, VT8, (char*)lds_raw, G, c, wv); } } PH_END
            PH_BEGIN(K_GQA) { bf16_t* QKV = (bf16_t*)BIG; gqa_attn_phase(QKV, AOB, (char*)lds_raw, G, c, wv, p.in[16], (const f32x2*)(ws + WS_T1), BIG + 192 * MiB, BIG + 208 * MiB); } PH_END
        } else {
#define DIL_PTRS(BC) bf16_t* QKVD = (bf16_t*)BIG; bf16_t* OG = (bf16_t*)(BIG + BIG_OG); float* LSE = (float*)(ws + WS_LSE); const size_t r0 = (size_t)(BC) * DIL_ROWS; (void)QKVD; (void)OG; (void)LSE; (void)r0;
#define DIL_QKV(BC) { DIL_PTRS(BC) pg8::Sched S{FP8_QKV2 ? (const char*)X8 + r0 * DM : (const char*)(XB + r0 * DM), (const char*)(WB + O_L2_QKV), 0, nullptr, nullptr, DIL_ROWS / 256, DIL_N / 256, G, c, 0, 0, (const char*)(SS + r0 * 16)}; pg8::EpiBf16 E{QKVD, FP8_QKVD ? -DIL_N : DIL_N}; \
                if (FP8_QKV2) pg8::gemm_phase<pg8::EpiBf16, false, GU_SW, GU_SA>(lds, 1024, S, E, wv); else pg8::gemm_phase<pg8::EpiBf16, false>(lds, 1024, S, E, wv); }
            PH_BEGIN(K_QKV2) DIL_QKV(0) PH_END
#pragma unroll 1
            for (int bc = 0; bc < NBATCH / DIL_CB; ++bc) {
                PH_BEGIN(K_DIL) { DIL_PTRS(bc) dil_attn_phase(QKVD, OG, LSE, (char*)lds_raw, G, c, wv, p.in[26], p.in[27], (const f32x2*)(ws + WS_T2)); } PH_END
                PH_BEGIN(K_MRG) { { DIL_PTRS(bc) dil_merge_phase(OG, LSE, AOB + r0 * DM, ((FP8_RES) & 4) ? (unsigned char*)out + OUT_AO8 + r0 * DM : nullptr, G, c, wv); }
                    if (bc + 1 < NBATCH / DIL_CB) { __syncthreads(); DIL_QKV(bc + 1) } } PH_END
            }
#undef DIL_PTRS
#undef DIL_QKV
        }
        PH_BEGIN(K_RES) { const bf16_t* Wo = WB + (L == 0 ? O_L0_WOUT : L == 1 ? O_L1_WOUT : L == 2 ? O_L2_WOUT : O_L3_WOUT);
            int Lr = L; asm volatile("" : "+s"(Lr)); const bool f8r = (((FP8_RES) >> Lr) & 1) != 0;
            pg8::Sched S{f8r ? (const char*)out + OUT_AO8 : (const char*)AOB, (const char*)Wo, 0, nullptr, nullptr, MT / 256, 4, G, c, 0, 0, nullptr}; const bool x8o = (L == 0) ? F8GU(0) : (L == 2) ? F8GU(2) : false;
            pg8::EpiResid E{XB, SS + (size_t)MT * 16, 0, x8o ? X8 : nullptr};
            if (f8r) pg8::gemm_phase<pg8::EpiResid, false, GU_SW, RES_SA>(lds, 1024, S, E, wv); else pg8::gemm_phase<pg8::EpiResid, false>(lds, 1024, S, E, wv); } PH_END
        const int fnorm = (L == 0) ? 11 : (L == 1) ? 19 : (L == 2) ? 29 : 42;
        if ((L & 1) == 0) {
#define FM_DECL int Lf = L; asm volatile("" : "+s"(Lf)); const int fm = (Lf == 0) ? (F8GU(0) * 2 + F8DN(0)) : (F8GU(2) * 2 + F8DN(2)); const bool f8g = (fm & 2) != 0, f8d = (fm & 1) != 0; (void)f8g; (void)f8d;
#define DENSE_GU(CK) { FM_DECL const bf16_t* Wgu = WB + (L ? O_L2_WGU : O_L0_WGU); void* HID = (void*)(BIG + (size_t)(CK) * (224 * MiB)); const size_t r0 = (size_t)(CK) * (MT / 2); const pg8::ss_t* ssf = SS + (size_t)MT * 16; \
                    pg8::Sched S{f8g ? (const char*)X8 + r0 * DM : (const char*)(XB + r0 * DM), (const char*)Wgu, 0, nullptr, nullptr, MT / 512, 28, G, c, 0, 0, (const char*)(ssf + r0 * 16)}; \
                    if (fm == 3) { pg8::EpiSwiglu<true, 1> E{HID}; pg8::gemm_phase<pg8::EpiSwiglu<true, 1>, false, GU_SW, GU_SA>(lds, 1024, S, E, wv); } \
                    else if (fm == 2) { pg8::EpiSwiglu<false, 1> E{HID}; pg8::gemm_phase<pg8::EpiSwiglu<false, 1>, false, GU_SW, GU_SA>(lds, 1024, S, E, wv); } \
                    else if (fm == 1) { pg8::EpiSwiglu<true, 1> E{HID}; pg8::gemm_phase<pg8::EpiSwiglu<true, 1>, false>(lds, 1024, S, E, wv); } \
                    else { pg8::EpiSwiglu<false, 1> E{HID}; pg8::gemm_phase<pg8::EpiSwiglu<false, 1>, false>(lds, 1024, S, E, wv); } }
#define DENSE_DN(CK) { FM_DECL const bf16_t* Wd = WB + (L ? O_L2_WD : O_L0_WD); const char* HID = (const char*)(BIG + (size_t)(CK) * (224 * MiB)); const size_t r0 = (size_t)(CK) * (MT / 2); \
                    pg8::Sched S{HID, (const char*)Wd, 0, nullptr, nullptr, MT / 512, 4, G, c, 0, 1, nullptr}; const bool x8n = (L == 0) ? (FP8_QKV1 != 0) : (((FP8_WIN) & 8) != 0); \
                    pg8::EpiResid E{XB, SS, (int)r0, x8n ? X8 : nullptr}; \
                    if (f8d) pg8::gemm_phase<pg8::EpiResid, false, DN_SW, DN_SA>(lds, DFF, S, E, wv); else pg8::gemm_phase<pg8::EpiResid, false>(lds, DFF, S, E, wv); }
            PH_BEGIN(K_GU) DENSE_GU(0) PH_END
            PH_BEGIN(K_DN) DENSE_DN(0) __syncthreads(); DENSE_GU(1) PH_END
            PH_BEGIN(K_DN) DENSE_DN(1) PH_END
#undef DENSE_GU
#undef DENSE_DN
#undef FM_DECL
        } else {
#define FM_DECL int Lf = L; asm volatile("" : "+s"(Lf)); const int fm = (Lf == 1) ? (F8GU(1) * 2 + F8DN(1)) : (F8GU(3) * 2 + F8DN(3)); const bool f8g = (fm & 2) != 0, f8d = (fm & 1) != 0; (void)f8g; (void)f8d;
            PH_BEGIN(K_NORMR) { FM_DECL const pg8::ss_t* ssf = SS + (size_t)MT * 16;
                if (f8g) prep_phase<true, 0, true>(XB, nullptr, ssf, nullptr, p.in[fnorm], p.in[fnorm + 1], p.in[fnorm + 2], X8, nullptr, ws, lds, G, c, wv);
                else prep_phase<true, 0, false>(XB, nullptr, ssf, nullptr, p.in[fnorm], p.in[fnorm + 1], p.in[fnorm + 2], X8, nullptr, ws, lds, G, c, wv); } PH_END
            PH_BEGIN(K_SCAT) moe_scatter_phase(ws, SS + (size_t)MT * 16, lds, G, c, wv); PH_END
#define MOE_PTRS FM_DECL const int* META = (const int*)(ws + WS_META); const int* SIDX = (const int*)(ws + WS_SIDX); const float* SGATE = (const float*)(ws + WS_SGATE); bf16_t* HID = (bf16_t*)BIG; \
                bf16_t* YB = (bf16_t*)(BIG + BIG_Y); const int ntt = META[33]; int nR = ntt - 512; nR = nR < 0 ? 0 : (nR > 8 ? 8 : nR); const pg8::ss_t* ssf = SS + (size_t)MT * 16; \
                const bf16_t* Wgu = WB + (L == 1 ? O_L1_WGU : O_L3_WGU); const bf16_t* Wd = WB + (L == 1 ? O_L1_WD : O_L3_WD); const char* XA = f8g ? (const char*)X8 : (const char*)XB; \
                (void)SIDX; (void)SGATE; (void)HID; (void)YB; (void)nR; (void)Wgu; (void)Wd; (void)ssf; (void)XA;
#define MOE_GU(S, HP, SR0) { if (fm == 3) { pg8::EpiSwiglu<true, 2> E{HP}; pg8::gemm_phase<pg8::EpiSwiglu<true, 2>, true, GU_SW, GU_SA>(lds, 1024, S, E, wv); } \
                         else if (fm == 2) { pg8::EpiSwiglu<false, 2> E{HP}; pg8::gemm_phase<pg8::EpiSwiglu<false, 2>, true, GU_SW, GU_SA>(lds, 1024, S, E, wv); } \
                         else if (fm == 1) { pg8::EpiSwiglu<true, 2> E{HP}; pg8::gemm_phase<pg8::EpiSwiglu<true, 2>, true>(lds, 1024, S, E, wv); } \
                         else { pg8::EpiSwiglu<false, 2> E{HP}; pg8::gemm_phase<pg8::EpiSwiglu<false, 2>, true>(lds, 1024, S, E, wv); } }
            static_assert(F8DN(1) && F8DN(3), "the MoE pipeline double-buffers an fp8 HID (2 x 112 MiB below BIG_HIDR)");
#define MOE_HID(CK) ((bf16_t*)(BIG + (size_t)((CK) & 1) * (112 * MiB)))
            PH_BEGIN(K_MGU) { MOE_PTRS pg8::Sched S{XA, (const char*)Wgu, E_WGU * 2, META, SIDX, 128, 28, G, c, 0, 0, (const char*)(ws + WS_SRS)};
#if PROBE_EPI == 1
                if (_rep) { pg8::EpiNull<2> E{}; pg8::gemm_phase<pg8::EpiNull<2>, true, GU_SW, GU_SA>(lds, 1024, S, E, wv); } else
#elif PROBE_EPI == 4
                if (_rep) { pg8::Sched S2 = S; S2.hot = 1; pg8::EpiNull<2> E{}; pg8::gemm_phase<pg8::EpiNull<2>, true, GU_SW, GU_SA>(lds, 1024, S2, E, wv); } else
#elif PROBE_EPI == 2
                if (_rep) { pg8::EpiSwiglu<true, 2> E{MOE_HID(1)}; pg8::gemm_phase<pg8::EpiSwiglu<true, 2>, true, GU_SW, GU_SA>(lds, 256, S, E, wv); } else
#endif
                MOE_GU(S, MOE_HID(0), 0) } PH_END
#pragma unroll 1
            for (int ck = 0; ck < 4; ++ck) {
                PH_BEGIN(K_MDN) { MOE_PTRS
#if PROBE_EPI == 5 || PROBE_EPI == 6
                    if (_rep) { pg8::Sched S{(const char*)MOE_HID(ck), (const char*)Wd, E_WD * 2, META, nullptr, 128, 4, G, c, 128 * ck, 1, nullptr}; S.hot = (PROBE_EPI == 5); pg8::EpiNull<0> E{}; pg8::gemm_phase<pg8::EpiNull<0>, false, DN_SW, DN_SA>(lds, DFF, S, E, wv); } else
#endif
                    { pg8::Sched S{(const char*)MOE_HID(ck), (const char*)Wd, E_WD * 2, META, nullptr, 128, 4, G, c, 128 * ck, 1, (const char*)SIDX, (const char*)SGATE}; pg8::EpiMoeY E{YB}; if (f8d) pg8::gemm_phase<pg8::EpiMoeY, false, DN_SW, DN_SA>(lds, DFF, S, E, wv); else pg8::gemm_phase<pg8::EpiMoeY, false>(lds, DFF, S, E, wv); }
                    __syncthreads();
                    if ((PROBE_EPI == 3 || PROBE_EPI == 5 || PROBE_EPI == 6) && _rep) {} else
                    if (ck < 3) { pg8::Sched S{XA, (const char*)Wgu, E_WGU * 2, META, SIDX, 128, 28, G, c, 128 * (ck + 1), 0, (const char*)(ws + WS_SRS)}; MOE_GU(S, MOE_HID(ck + 1), 0) }
                    else if (nR > 0) { pg8::Sched S{XA, (const char*)Wgu, E_WGU * 2, META, SIDX, nR, 28, G, c, 512, 0, (const char*)(ws + WS_SRS)}; MOE_GU(S, (bf16_t*)(BIG + BIG_HIDR), 0) } } PH_END
            }
#undef MOE_HID
            PH_BEGIN(K_MDR) { MOE_PTRS
                if (nR > 0) { pg8::Sched S{(const char*)(BIG + BIG_HIDR), (const char*)Wd, E_WD * 2, META, nullptr, nR, 4, G, c, 512, 1, (const char*)SIDX, (const char*)SGATE}; pg8::EpiMoeY E{YB}; if (f8d) pg8::gemm_phase<pg8::EpiMoeY, false, DN_SW, DN_SA>(lds, DFF, S, E, wv); else pg8::gemm_phase<pg8::EpiMoeY, false>(lds, DFF, S, E, wv); }
                if (LATE_CVT && L == 1 && c >= 32) late_convert_l3gu(p, lds, G - 32, c - 32, wv); } PH_END
#undef MOE_PTRS
#undef MOE_GU
#undef FM_DECL
            if (L == 1) { PH_BEGIN(K_NORMY) prep_phase<false, 1, FP8_QKV2 != 0>(XB, (const bf16_t*)(BIG + BIG_Y), nullptr, SS, nullptr, nullptr, nullptr, X8, nullptr, ws, lds, G, c, wv); PH_END }
            if (L == 3) { PH_BEGIN(K_FIN) prep_phase<false, 2, false>(XB, (const bf16_t*)(BIG + BIG_Y), nullptr, nullptr, nullptr, nullptr, nullptr, nullptr, out, ws, lds, G, c, wv); PH_END }
        }
    }
#undef PH_BEGIN
#undef PH_END
}

constexpr int N_PHASES = 1 + (4 + 1 + 3) + (3 + 1 + 2 + 6 + 1) + (9 + 1 + 3) + (4 + 1 + 2 + 6 + 1);
struct KindTab { int k[N_PHASES + 8]; int n; };
constexpr KindTab build_kinds() {
    KindTab t{}; int n = 0; t.k[n++] = K_PRO;
    for (int L = 0; L < 4; ++L) {
        if (L == 0 || L == 3) { t.k[n++] = K_WIN; t.k[n++] = K_RG0; t.k[n++] = K_RGC; t.k[n++] = K_RG1; }
        else if (L == 1) { t.k[n++] = K_QKV1; t.k[n++] = K_QKNA; t.k[n++] = K_GQA; }
        else { t.k[n++] = K_QKV2; for (int bc = 0; bc < NBATCH / DIL_CB; ++bc) { t.k[n++] = K_DIL; t.k[n++] = K_MRG; } }
        t.k[n++] = K_RES;
        if ((L & 1) == 0) { t.k[n++] = K_GU; t.k[n++] = K_DN; t.k[n++] = K_DN; }
        else { t.k[n++] = K_NORMR; t.k[n++] = K_SCAT; t.k[n++] = K_MGU; for (int ck = 0; ck < 4; ++ck) t.k[n++] = K_MDN; t.k[n++] = K_MDR; t.k[n++] = (L == 1) ? K_NORMY : K_FIN; }
    }
    t.n = n; return t;
}
constexpr KindTab KINDS = build_kinds();
static_assert(KINDS.n == N_PHASES, "phase count");
typedef void (*mega_fn)(Params);
template <int K> struct FnTab { static void fill(mega_fn* f) { f[K] = mega<(1u << K)>; FnTab<K - 1>::fill(f); } };
template <> struct FnTab<-1> { static void fill(mega_fn*) {} };

extern "C" void kernel_launch(void* const* d_in, const int* in_sizes, int n_in, void* d_out, int out_size, void* d_ws, size_t ws_size, hipStream_t stream) {
    static int ok = 0; static mega_fn fns[K_COUNT + 1];
    if (ok == 0) {
        if (n_in != 47 || out_size != MT * DM || ws_size < WS_END) { fprintf(stderr, "kernel_launch: unexpected shapes: n_in %d out %d ws %zu (need %zu)\n", n_in, out_size, ws_size, (size_t)WS_END); ok = -1; return; }
#if SPLIT_LAUNCHES
        FnTab<K_COUNT - 1>::fill(fns);
        for (int k = 0; k < K_COUNT; ++k)
            if (hipFuncSetAttribute((const void*)fns[k], hipFuncAttributeMaxDynamicSharedMemorySize, LDS_BYTES) != hipSuccess) { fprintf(stderr, "kernel_launch: hipFuncSetAttribute failed\n"); ok = -1; return; }
#else
        fns[K_COUNT] = mega<ALL_KINDS>;
        if (hipFuncSetAttribute((const void*)fns[K_COUNT], hipFuncAttributeMaxDynamicSharedMemorySize, LDS_BYTES) != hipSuccess) { fprintf(stderr, "kernel_launch: hipFuncSetAttribute failed\n"); ok = -1; return; }
#endif
        ok = 1;
    }
    if (ok < 0) return;
    (void)hipMemsetAsync((char*)d_ws + WS_CTL, 0, 65536, stream);
    Params p{};
    for (int i = 0; i < 47; ++i) p.in[i] = (const float*)d_in[i];
    p.out = (float*)d_out; p.ws = (unsigned char*)d_ws;
    const int nph = N_PHASES < PHASE_LIMIT ? N_PHASES : PHASE_LIMIT;
#if SPLIT_LAUNCHES
    for (int ph = 0; ph < nph; ++ph) { p.lo = ph; p.hi = ph + 1; hipLaunchKernelGGL(fns[KINDS.k[ph]], dim3(NWG), dim3(512), LDS_BYTES, stream, p); }
#else
    p.lo = 0; p.hi = nph; hipLaunchKernelGGL(fns[K_COUNT], dim3(NWG), dim3(512), LDS_BYTES, stream, p);
#endif
    const hipError_t le = hipPeekAtLastError();
    if (le != hipSuccess) fprintf(stderr, "kernel_launch: launch failed: %s\n", hipGetErrorName(le));
}
```
